# Optimizing an MI355X kernel written in HIP

```python
import math
import jax, jax.numpy as jnp
from jax import lax
import numpy as np

D_MODEL = 2048
BATCH = 8
SEQ = 2048
DEPTH = 2

W_RWKV = D_MODEL // 4
HEAD_DIM_RWKV = 64
N_HEADS_RWKV = W_RWKV // HEAD_DIM_RWKV
LORA_DECAY = 64
LORA_ICLR = 64
LORA_VRES = 32
LORA_GATE = 128
RWKV_GN_EPS = 64e-5
W_GDN = D_MODEL // 4
HEAD_DIM_GDN = 128
N_HEADS_GDN = W_GDN // HEAD_DIM_GDN
CONV_WIDTH = 4
GDN_CHUNK = 64
W_DIFF = D_MODEL // 2
HEAD_DIM_DIFF = 64
N_HEADS_DIFF = W_DIFF // (2 * HEAD_DIM_DIFF)
Q_BLOCK = 128
RWKV_COLS = 3 * W_RWKV + LORA_DECAY + LORA_ICLR + LORA_GATE
GDN_COLS = 4 * W_GDN + 2 * N_HEADS_GDN
DIFF_COLS = 3 * W_DIFF
N_IN = RWKV_COLS + GDN_COLS + DIFF_COLS
MIX_WIDTH = W_RWKV + W_GDN + W_DIFF
FFN_HIDDEN = -(-8 * D_MODEL // (3 * 256)) * 256
NORM_EPS = 1e-6

kernel_name = "hybrid_rwkv7_gdn_diffattn_block"


def rms_norm(x, w, eps=NORM_EPS):
    xf = x.astype(jnp.float32)
    y = xf * lax.rsqrt(jnp.mean(xf * xf, axis=-1, keepdims=True) + eps)
    return (y * w.astype(jnp.float32)).astype(x.dtype)


def l2_normalize(x, eps=NORM_EPS):
    xf = x.astype(jnp.float32)
    return xf * lax.rsqrt(jnp.sum(xf * xf, axis=-1, keepdims=True) + eps)


def token_shift(x):
    return jnp.pad(x, ((0, 0), (1, 0), (0, 0)))[:, :-1]


def causal_depthwise_conv(x, w):
    k, c = w.shape
    return lax.conv_general_dilated(
        x, w[:, None, :].astype(x.dtype), window_strides=(1,), padding=[(k - 1, 0)],
        dimension_numbers=("NWC", "WIO", "NWC"), feature_group_count=c)


def wkv7_scan(r, decay, k, v, a, b):
    bsz, _, h, n = r.shape

    def step(s, inp):
        r_t, w_t, k_t, v_t, a_t, b_t = inp
        sa = jnp.einsum("bhij,bhj->bhi", s, a_t)
        s = s * w_t[:, :, None, :] + sa[..., None] * b_t[:, :, None, :] + v_t[..., None] * k_t[:, :, None, :]
        return s, jnp.einsum("bhij,bhj->bhi", s, r_t)

    xs = tuple(jnp.moveaxis(t, 1, 0) for t in (r, decay, k, v, a, b))
    _, ys = lax.scan(step, jnp.zeros((bsz, h, n, n), jnp.float32), xs)
    return jnp.moveaxis(ys, 0, 1)


def rwkv7_time_mix(p, v_first, w0, w_lora_b, a0, a_lora_b, g_lora_b, k_k, k_a, r_k,
                   ln_w, ln_b, v0, v_lora_b):
    bsz, t, _ = p.shape
    h, n, wd = N_HEADS_RWKV, HEAD_DIM_RWKV, W_RWKV
    r = p[..., 0:wd]
    k = p[..., wd:2 * wd]
    v = p[..., 2 * wd:3 * wd]
    o = 3 * wd
    xw = p[..., o:o + LORA_DECAY]
    o += LORA_DECAY
    xa = p[..., o:o + LORA_ICLR]
    o += LORA_ICLR
    xg = p[..., o:o + LORA_GATE]
    w_log = -jax.nn.softplus(-(w0 + jnp.tanh(xw) @ w_lora_b)) - 0.5
    if v0 is None:
        v_first = v
    else:
        xv = p[..., RWKV_COLS:]
        v = v + (v_first - v) * jax.nn.sigmoid(v0 + xv @ v_lora_b)
    a = jax.nn.sigmoid(a0 + xa @ a_lora_b)
    g = jax.nn.sigmoid(xg) @ g_lora_b
    heads = lambda z: z.reshape(bsz, t, h, n).astype(jnp.float32)
    kk = l2_normalize(heads(k * k_k))
    k = k * (1.0 + (a - 1.0) * k_a)
    rh, kh, vh, ah = heads(r), heads(k), heads(v), heads(a)
    decay = jnp.exp(-jnp.exp(heads(w_log)))
    y = wkv7_scan(rh, decay, kh, vh, -kk, kk * ah)
    mean = jnp.mean(y, axis=-1, keepdims=True)
    var = jnp.mean(jnp.square(y - mean), axis=-1, keepdims=True)
    y = (y - mean) * lax.rsqrt(var + RWKV_GN_EPS)
    y = y * ln_w.reshape(h, n).astype(jnp.float32) + ln_b.reshape(h, n).astype(jnp.float32)
    bonus = jnp.sum(rh * kh * r_k.astype(jnp.float32), axis=-1, keepdims=True) * vh
    out = (y + bonus).reshape(bsz, t, wd).astype(p.dtype) * g
    return out, v_first


def gated_delta_rule_chunked(q, k, v, g, beta):
    bsz, t, h, dk = q.shape
    dv = v.shape[-1]
    c = GDN_CHUNK
    nc = t // c
    ch4 = lambda z: z.reshape(bsz, nc, c, h, z.shape[-1]).transpose(0, 3, 1, 2, 4)
    ch3 = lambda z: z.reshape(bsz, nc, c, h).transpose(0, 3, 1, 2)
    q, k, v = ch4(q * dk ** -0.5), ch4(k), ch4(v)
    g, beta = ch3(g), ch3(beta)
    gc = jnp.cumsum(g, axis=-1)
    idx = jnp.arange(c)
    causal = idx[:, None] >= idx[None, :]
    strict = idx[:, None] > idx[None, :]
    decay = jnp.exp(jnp.where(causal, gc[..., :, None] - gc[..., None, :], -jnp.inf))
    kb = k * beta[..., None]
    m = jnp.where(strict, jnp.einsum("bhnik,bhnjk->bhnij", kb, k) * decay, 0.0)
    lhs = jnp.eye(c, dtype=jnp.float32) + m
    rhs = jnp.concatenate([v * beta[..., None], kb * jnp.exp(gc)[..., None]], axis=-1)
    sol = lax.linalg.triangular_solve(lhs, rhs, left_side=True, lower=True, unit_diagonal=True)
    u, w = sol[..., :dv], sol[..., dv:]
    attn = jnp.einsum("bhnik,bhnjk->bhnij", q, k) * decay
    q_dec = q * jnp.exp(gc)[..., None]
    k_dec = k * jnp.exp(gc[..., -1:] - gc)[..., None]
    g_last = jnp.exp(gc[..., -1])

    def step(s, inp):
        u_c, w_c, q_c, k_c, a_c, gl = inp
        v_new = u_c - jnp.einsum("bhck,bhkv->bhcv", w_c, s)
        o = jnp.einsum("bhck,bhkv->bhcv", q_c, s) + jnp.einsum("bhcj,bhjv->bhcv", a_c, v_new)
        s = s * gl[..., None, None] + jnp.einsum("bhck,bhcv->bhkv", k_c, v_new)
        return s, o

    xs = tuple(jnp.moveaxis(z, 2, 0) for z in (u, w, q_dec, k_dec, attn, g_last))
    _, o = lax.scan(step, jnp.zeros((bsz, h, dk, dv), jnp.float32), xs)
    return o.transpose(1, 0, 3, 2, 4).reshape(bsz, t, h, dv)


def gated_deltanet(p, conv_w, a_log, dt_bias, norm_w):
    bsz, t, _ = p.shape
    h, d, wd = N_HEADS_GDN, HEAD_DIM_GDN, W_GDN
    qkv = jax.nn.silu(causal_depthwise_conv(p[..., :3 * wd], conv_w))
    z = p[..., 3 * wd:4 * wd].reshape(bsz, t, h, d)
    a = p[..., 4 * wd:4 * wd + h].astype(jnp.float32)
    b = p[..., 4 * wd + h:4 * wd + 2 * h].astype(jnp.float32)
    q = l2_normalize(qkv[..., :wd].reshape(bsz, t, h, d))
    k = l2_normalize(qkv[..., wd:2 * wd].reshape(bsz, t, h, d))
    v = qkv[..., 2 * wd:].reshape(bsz, t, h, d).astype(jnp.float32)
    beta = jax.nn.sigmoid(b)
    g = -jnp.exp(a_log.astype(jnp.float32)) * jax.nn.softplus(a + dt_bias.astype(jnp.float32))
    o = gated_delta_rule_chunked(q, k, v, g, beta).astype(p.dtype)
    o = rms_norm(o, norm_w) * jax.nn.silu(z)
    return o.reshape(bsz, t, wd)


def differential_attention(p, q_norm_w, k_norm_w, lq1, lk1, lq2, lk2, subln_w, lambda_init):
    bsz, t, _ = p.shape
    h, d, wd = N_HEADS_DIFF, HEAD_DIM_DIFF, W_DIFF
    q = rms_norm(p[..., :wd].reshape(bsz, t, h, 2, d), q_norm_w)
    k = rms_norm(p[..., wd:2 * wd].reshape(bsz, t, h, 2, d), k_norm_w)
    v = p[..., 2 * wd:3 * wd].reshape(bsz, t, h, 2 * d)
    f32 = jnp.float32
    lam = (jnp.exp(jnp.sum(lq1.astype(f32) * lk1.astype(f32)))
           - jnp.exp(jnp.sum(lq2.astype(f32) * lk2.astype(f32))) + lambda_init)
    scale = d ** -0.5
    outs = []
    for i in range(t // Q_BLOCK):
        s0 = i * Q_BLOCK
        end = s0 + Q_BLOCK
        s = jnp.einsum("bqhmd,bkhmd->bhmqk", q[:, s0:end], k[:, :end]).astype(f32) * scale
        mask = jnp.arange(end)[None, :] <= (s0 + jnp.arange(Q_BLOCK))[:, None]
        prob = jax.nn.softmax(jnp.where(mask, s, -jnp.inf), axis=-1)
        pdiff = prob[:, :, 0] - lam * prob[:, :, 1]
        outs.append(jnp.einsum("bhqk,bkhe->bqhe", pdiff.astype(v.dtype), v[:, :end]))
    o = jnp.concatenate(outs, axis=1)
    o = rms_norm(o, subln_w) * (1.0 - lambda_init)
    return o.reshape(bsz, t, wd)


def setup_inputs(seed: int = 0) -> dict:
    key = jax.random.key(seed)
    ks = iter(jax.random.split(key, 48))
    nrm = lambda shape, scale: scale * jax.random.normal(next(ks), shape, jnp.float32)
    uni = lambda shape, lo, hi: jax.random.uniform(next(ks), shape, jnp.float32, lo, hi)
    L, Lv, D = DEPTH, DEPTH - 1, D_MODEL
    dt = jnp.exp(uni((L, N_HEADS_GDN), math.log(1e-3), math.log(1e-1)))
    return {
        "x": nrm((BATCH, SEQ, D), 1.0),
        "attn_norm_w": 1.0 + nrm((L, D), 0.02),
        "w_in": nrm((L, D, N_IN), D ** -0.5),
        "w_vres_a": nrm((Lv, D, LORA_VRES), D ** -0.5),
        "mu_rwkv": uni((L, RWKV_COLS), 0.0, 1.0),
        "mu_vres": uni((Lv, LORA_VRES), 0.0, 1.0),
        "rwkv_w0": uni((L, W_RWKV), -5.0, 1.0),
        "rwkv_w_lora_b": nrm((L, LORA_DECAY, W_RWKV), 0.5 * LORA_DECAY ** -0.5),
        "rwkv_a0": nrm((L, W_RWKV), 0.5),
        "rwkv_a_lora_b": nrm((L, LORA_ICLR, W_RWKV), 0.5 * LORA_ICLR ** -0.5),
        "rwkv_g_lora_b": nrm((L, LORA_GATE, W_RWKV), LORA_GATE ** -0.5),
        "rwkv_v0": nrm((Lv, W_RWKV), 0.5),
        "rwkv_v_lora_b": nrm((Lv, LORA_VRES, W_RWKV), 0.5 * LORA_VRES ** -0.5),
        "rwkv_k_k": 0.85 + nrm((L, W_RWKV), 0.02),
        "rwkv_k_a": 1.0 + nrm((L, W_RWKV), 0.02),
        "rwkv_r_k": nrm((L, N_HEADS_RWKV, HEAD_DIM_RWKV), 0.1),
        "rwkv_ln_w": 1.0 + nrm((L, W_RWKV), 0.02),
        "rwkv_ln_b": nrm((L, W_RWKV), 0.02),
        "gdn_conv_w": nrm((L, CONV_WIDTH, 3 * W_GDN), CONV_WIDTH ** -0.5),
        "gdn_A_log": jnp.log(uni((L, N_HEADS_GDN), 1.0, 16.0)),
        "gdn_dt_bias": dt + jnp.log(-jnp.expm1(-dt)),
        "gdn_norm_w": 1.0 + nrm((L, HEAD_DIM_GDN), 0.02),
        "diff_q_norm_w": 1.0 + nrm((L, HEAD_DIM_DIFF), 0.02),
        "diff_k_norm_w": 1.0 + nrm((L, HEAD_DIM_DIFF), 0.02),
        "diff_lambda_q1": nrm((L, HEAD_DIM_DIFF), 0.1),
        "diff_lambda_k1": nrm((L, HEAD_DIM_DIFF), 0.1),
        "diff_lambda_q2": nrm((L, HEAD_DIM_DIFF), 0.1),
        "diff_lambda_k2": nrm((L, HEAD_DIM_DIFF), 0.1),
        "diff_subln_w": 1.0 + nrm((L, 2 * HEAD_DIM_DIFF), 0.02),
        "w_out": nrm((L, MIX_WIDTH, D), MIX_WIDTH ** -0.5),
        "ffn_norm_w": 1.0 + nrm((L, D), 0.02),
        "w_ffn_in": nrm((L, D, 2 * FFN_HIDDEN), D ** -0.5),
        "w_ffn_out": nrm((L, FFN_HIDDEN, D), FFN_HIDDEN ** -0.5),
    }


def reference(x, attn_norm_w, w_in, w_vres_a, mu_rwkv, mu_vres, rwkv_w0, rwkv_w_lora_b,
              rwkv_a0, rwkv_a_lora_b, rwkv_g_lora_b, rwkv_v0, rwkv_v_lora_b, rwkv_k_k,
              rwkv_k_a, rwkv_r_k, rwkv_ln_w, rwkv_ln_b, gdn_conv_w, gdn_A_log, gdn_dt_bias,
              gdn_norm_w, diff_q_norm_w, diff_k_norm_w, diff_lambda_q1, diff_lambda_k1,
              diff_lambda_q2, diff_lambda_k2, diff_subln_w, w_out, ffn_norm_w, w_ffn_in,
              w_ffn_out):
    v_first = None
    for l in range(DEPTH):
        h = rms_norm(x, attn_norm_w[l])
        if l == 0:
            w_proj, mu = w_in[l], mu_rwkv[l]
        else:
            w_proj = jnp.concatenate([w_in[l], w_vres_a[l - 1]], axis=1)
            mu = jnp.concatenate([mu_rwkv[l], mu_vres[l - 1]])
        p = h @ w_proj
        p_rw = p[..., :RWKV_COLS] if l == 0 else jnp.concatenate([p[..., :RWKV_COLS], p[..., N_IN:]], axis=-1)
        p_rw = p_rw + (token_shift(p_rw) - p_rw) * mu
        p_gdn = p[..., RWKV_COLS:RWKV_COLS + GDN_COLS]
        p_diff = p[..., RWKV_COLS + GDN_COLS:N_IN]
        if l == 0:
            y_rw, v_first = rwkv7_time_mix(
                p_rw, None, rwkv_w0[l], rwkv_w_lora_b[l], rwkv_a0[l], rwkv_a_lora_b[l],
                rwkv_g_lora_b[l], rwkv_k_k[l], rwkv_k_a[l], rwkv_r_k[l], rwkv_ln_w[l],
                rwkv_ln_b[l], None, None)
        else:
            y_rw, _ = rwkv7_time_mix(
                p_rw, v_first, rwkv_w0[l], rwkv_w_lora_b[l], rwkv_a0[l], rwkv_a_lora_b[l],
                rwkv_g_lora_b[l], rwkv_k_k[l], rwkv_k_a[l], rwkv_r_k[l], rwkv_ln_w[l],
                rwkv_ln_b[l], rwkv_v0[l - 1], rwkv_v_lora_b[l - 1])
        y_gdn = gated_deltanet(p_gdn, gdn_conv_w[l], gdn_A_log[l], gdn_dt_bias[l], gdn_norm_w[l])
        lambda_init = 0.8 - 0.6 * math.exp(-0.3 * l)
        y_diff = differential_attention(
            p_diff, diff_q_norm_w[l], diff_k_norm_w[l], diff_lambda_q1[l], diff_lambda_k1[l],
            diff_lambda_q2[l], diff_lambda_k2[l], diff_subln_w[l], lambda_init)
        mixed = jnp.concatenate([y_rw, y_gdn, y_diff], axis=-1)
        x = x + mixed @ w_out[l]
        h = rms_norm(x, ffn_norm_w[l])
        gate, up = jnp.split(h @ w_ffn_in[l], 2, axis=-1)
        x = x + (jax.nn.silu(gate) * up) @ w_ffn_out[l]
    return x
```

```cpp
#include <hip/hip_runtime.h>
#include <hip/hip_cooperative_groups.h>
#include <cstdio>
#include <cstdint>
namespace cg = cooperative_groups;
namespace pg8 {
#define PG8_LAS __attribute__((address_space(3)))
typedef unsigned short bf16_t;
typedef short bf16x8 __attribute__((ext_vector_type(8)));
typedef float f32x4 __attribute__((ext_vector_type(4)));
typedef unsigned u32x4 __attribute__((ext_vector_type(4)));
constexpr int BM = 256, BK = 64, HALF = 128, HTB = HALF * BK * 2  , STAGE_BYTES = 8 * HTB, NXCD = 8, WGM = 8;

__host__ __device__ __forceinline__ int lds_byte(int r, int c) { const int st = (r >> 4) * 2 + (c >> 5), rr = r & 15, cc = c & 31, ob = rr * 64 + cc * 2; return st * 1024 + (ob ^ (((ob >> 9) & 1) << 5)); }
__host__ __device__ __forceinline__ void stage_rc(int b, int& R, int& C) { const int st = b / 1024, sb = b % 1024, swz = sb ^ (((sb >> 9) & 1) << 5); R = (st >> 1) * 16 + swz / 64; C = (st & 1) * 32 + (swz % 64) / 2; }
__host__ __device__ __forceinline__ int perm32(int rho) { const int n = rho >> 4, i = rho & 15; return 8 * (i >> 2) + 4 * n + (i & 3); }

struct Unit { int pm, pn; };
struct Gemm { const bf16_t* A; const bf16_t* Bt; int M, N, K; };

struct StaticOrder {
    int nM, nN, nwg, G, c;
    __host__ __device__ void init(int M, int N, int G_, int c_) { nM = M / BM; nN = N / BM; nwg = nM * nN; G = G_; c = c_; }
    __host__ __device__ bool next(int i, Unit& u) const {
        const long L = (long)i * G + c; if (L >= nwg) return false;
        int wgid = (int)L; { const int q = nwg / NXCD, r = nwg % NXCD, xcd = wgid % NXCD, off = wgid / NXCD; wgid = (xcd < r ? xcd * (q + 1) : r * (q + 1) + (xcd - r) * q) + off; }
        const int nig = WGM * nN, gid = wgid / nig, fm = gid * WGM, gsz = (nM - fm) < WGM ? (nM - fm) : WGM;
        u.pm = fm + ((wgid % nig) % gsz); u.pn = (wgid % nig) / gsz; return true;
    }
    __device__ __forceinline__ void a_ready(const Unit&) const {}
    __device__ __forceinline__ void done(const Unit&) const {}
};

__device__ __forceinline__ unsigned cvt_pk_bf16(float lo, float hi) { unsigned r; asm volatile("v_cvt_pk_bf16_f32 %0, %1, %2" : "=v"(r) : "v"(lo), "v"(hi)); return r; }
struct EpiBf16 {
    static constexpr bool PERM = true, AFTER_DRAIN = false;
    bf16_t* O; int ldc;
    __device__ __forceinline__ void operator()(const f32x4 (&acc)[2][2][4][2], const Unit& u, int wr, int wc, int fr, int fq) const {
        const int row0 = u.pm * BM + wr * 64 + fr; const int col0 = u.pn * BM + wc * 32 + 8 * fq;
#pragma unroll
        for (int ai = 0; ai < 2; ++ai)
#pragma unroll
            for (int m = 0; m < 4; ++m) { bf16_t* rowp = O + (size_t)(row0 + ai * HALF + m * 16) * ldc + col0;
#pragma unroll
                for (int bj = 0; bj < 2; ++bj) { const f32x4 v0 = acc[ai][bj][m][0], v1 = acc[ai][bj][m][1];
                    u32x4 w; w.x = cvt_pk_bf16(v0[0], v0[1]); w.y = cvt_pk_bf16(v0[2], v0[3]); w.z = cvt_pk_bf16(v1[0], v1[1]); w.w = cvt_pk_bf16(v1[2], v1[3]);
                    *(u32x4*)(rowp + bj * HALF) = w; } }
    }
};
struct EpiSwiglu {
    static constexpr bool PERM = true, AFTER_DRAIN = false;
    bf16_t* O; int ldc;
    __device__ __forceinline__ void operator()(const f32x4 (&acc)[2][2][4][2], const Unit& u, int wr, int wc, int fr, int fq) const {
        typedef unsigned u32x2 __attribute__((ext_vector_type(2)));
        const int row0 = u.pm * BM + wr * 64 + fr; const int col0 = u.pn * 128 + wc * 16 + 4 * fq;
#pragma unroll
        for (int ai = 0; ai < 2; ++ai)
#pragma unroll
            for (int m = 0; m < 4; ++m) { bf16_t* rowp = O + (size_t)(row0 + ai * HALF + m * 16) * ldc + col0;
#pragma unroll
                for (int bj = 0; bj < 2; ++bj) { const f32x4 g = acc[ai][bj][m][0], up = acc[ai][bj][m][1]; float a[4];
#pragma unroll
                    for (int e = 0; e < 4; ++e) a[e] = g[e] * __builtin_amdgcn_rcpf(1.0f + __expf(-g[e])) * up[e];
                    u32x2 w; w.x = cvt_pk_bf16(a[0], a[1]); w.y = cvt_pk_bf16(a[2], a[3]);
                    *(u32x2*)(rowp + bj * 64) = w; } }
    }
};
struct EpiResAdd {
    static constexpr bool PERM = false, AFTER_DRAIN = false;
    const float* base; float* out; int ldc;
    __device__ __forceinline__ void operator()(const f32x4 (&acc)[2][2][4][2], const Unit& u, int wr, int wc, int fr, int fq) const {
        const int row0 = u.pm * BM + wr * 64 + fr; const int col0 = u.pn * BM + wc * 32 + 4 * fq;
#pragma unroll
        for (int ai = 0; ai < 2; ++ai) {
            f32x4 b[4][2][2];
#pragma unroll
            for (int m = 0; m < 4; ++m) { const size_t off = (size_t)(row0 + ai * HALF + m * 16) * ldc + col0;
#pragma unroll
                for (int bj = 0; bj < 2; ++bj)
#pragma unroll
                    for (int n = 0; n < 2; ++n) b[m][bj][n] = *(const f32x4*)(base + off + bj * HALF + n * 16); }
            asm volatile("" ::: "memory");
#pragma unroll
            for (int m = 0; m < 4; ++m) { const size_t off = (size_t)(row0 + ai * HALF + m * 16) * ldc + col0;
#pragma unroll
                for (int bj = 0; bj < 2; ++bj)
#pragma unroll
                    for (int n = 0; n < 2; ++n) *(f32x4*)(out + off + bj * HALF + n * 16) = b[m][bj][n] + acc[ai][bj][m][n]; }
        }
    }
};
template <class Epi, class Sched, bool ALIGN_EPI = false, bool SP2 = false>
__device__ __forceinline__ void gemm_phase(PG8_LAS unsigned char* lds, const Gemm g, const Sched& S, const Epi& E) {
    int tid = threadIdx.x; asm volatile("" : "+v"(tid)); const int wid = __builtin_amdgcn_readfirstlane(tid >> 6), lane = tid & 63, wr = wid >> 2, wc = wid & 3, fr = lane & 15, fq = lane >> 4;
    const int K = g.K, nt = K / BK;
    unsigned voffA[2], voffB[2];
#pragma unroll
    for (int i = 0; i < 2; ++i) { int R, C; stage_rc(tid * 16 + i * 8192, R, C); const int Rb = Epi::PERM ? ((R & ~31) + perm32(R & 31)) : R;
        voffA[i] = (unsigned)(R * K + C) * 2u; voffB[i] = (unsigned)(Rb * K + C) * 2u; }
    const size_t kstep = (size_t)(BK * 2);
    const size_t hstep = (size_t)HALF * K * 2;
    const size_t tstep = 2 * hstep;
    const unsigned ldsw = (unsigned)wid * 1024u;
    const int aoff = lds_byte(wr * 64 + fr, fq * 8), boff = lds_byte(wc * 32 + fr, fq * 8);
#define PG8_SA(b, h) (((b) * 2 + (h)) * HTB)
#define PG8_SB(b, h) ((4 + (b) * 2 + (h)) * HTB)
#define PG8_STAGE(bufoff, gbase, voff) do { _Pragma("unroll") for (int _i = 0; _i < 2; ++_i) \
        __builtin_amdgcn_global_load_lds((const unsigned*)((const char*)(gbase) + (voff)[_i]), (PG8_LAS unsigned*)(lds + (bufoff) + ldsw + _i * 8192), 16, 0, 0); } while (0)
#define PG8_LDA(dst, b, h) do { _Pragma("unroll") for (int m = 0; m < 4; ++m) _Pragma("unroll") for (int k = 0; k < 2; ++k) dst[m][k] = *(const PG8_LAS bf16x8*)(lds + PG8_SA(b, h) + aoff + m * 2048 + k * 1024); } while (0)
#define PG8_LDB(dst, b, h) do { _Pragma("unroll") for (int n = 0; n < 2; ++n) _Pragma("unroll") for (int k = 0; k < 2; ++k) dst[n][k] = *(const PG8_LAS bf16x8*)(lds + PG8_SB(b, h) + boff + n * 2048 + k * 1024); } while (0)
#define PG8_MMA(ai, bj, At, Bt) do { __builtin_amdgcn_s_setprio(1); _Pragma("unroll") for (int m = 0; m < 4; ++m) _Pragma("unroll") for (int n = 0; n < 2; ++n) _Pragma("unroll") for (int k = 0; k < 2; ++k) \
        acc[ai][bj][m][n] = __builtin_amdgcn_mfma_f32_16x16x32_bf16(Bt[n][k], At[m][k], acc[ai][bj][m][n], 0, 0, 0); __builtin_amdgcn_s_setprio(0); } while (0)
#define PG8_WAIT_V(n) asm volatile("s_waitcnt vmcnt(" #n ")" ::: "memory")
#define PG8_WAIT_L(n) asm volatile("s_waitcnt lgkmcnt(" #n ")" ::: "memory")
#define PG8_BAR __builtin_amdgcn_s_barrier()
#define PG8_SCHED __builtin_amdgcn_sched_barrier(0)
    Unit cur, nxt; int ui = 0;
    if (!S.next(0, cur)) return;
    f32x4 acc[2][2][4][2];
#pragma unroll
    for (int a = 0; a < 2; ++a)
#pragma unroll
        for (int b = 0; b < 2; ++b)
#pragma unroll
            for (int m = 0; m < 4; ++m)
#pragma unroll
                for (int n = 0; n < 2; ++n) acc[a][b][m][n] = (f32x4){0.f, 0.f, 0.f, 0.f};
    bf16x8 At[4][2], B0[2][2], B1[2][2];
    const char* cA = (const char*)g.A + (size_t)cur.pm * tstep; const char* cB = (const char*)g.Bt + (size_t)cur.pn * tstep;
    S.a_ready(cur);
    if constexpr (SP2) {
        PG8_STAGE(PG8_SB(0, 0), cB, voffB); PG8_STAGE(PG8_SB(0, 1), cB + hstep, voffB); PG8_STAGE(PG8_SA(0, 0), cA, voffA); PG8_STAGE(PG8_SA(0, 1), cA + hstep, voffA);
        if (wr == 1) PG8_BAR;
        PG8_WAIT_V(2); PG8_BAR;
        PG8_STAGE(PG8_SB(1, 0), cB + kstep, voffB); PG8_STAGE(PG8_SA(1, 0), cA + kstep, voffA); PG8_STAGE(PG8_SB(1, 1), cB + hstep + kstep, voffB);
        PG8_WAIT_V(6); PG8_BAR;
    } else {
        PG8_STAGE(PG8_SB(0, 0), cB, voffB); PG8_STAGE(PG8_SA(0, 0), cA, voffA); PG8_STAGE(PG8_SB(0, 1), cB + hstep, voffB); PG8_STAGE(PG8_SA(0, 1), cA + hstep, voffA);
        if (wr == 1) PG8_BAR;
        PG8_WAIT_V(4); PG8_BAR;
        PG8_STAGE(PG8_SB(1, 0), cB + kstep, voffB); PG8_STAGE(PG8_SA(1, 0), cA + kstep, voffA); PG8_STAGE(PG8_SB(1, 1), cB + hstep + kstep, voffB);
        PG8_WAIT_V(6); PG8_BAR;
    }
    for (;;) {
        const bool has_next = S.next(ui + 1, nxt);
        const char* nA = has_next ? (const char*)g.A + (size_t)nxt.pm * tstep : cA; const char* nB = has_next ? (const char*)g.Bt + (size_t)nxt.pn * tstep : cB;
        for (int t = 0; t < nt; t += 2) {
            const bool last = (t == nt - 2);
            const char* a1 = cA + (size_t)(t + 1) * kstep;
            const char* a2 = last ? nA : cA + (size_t)(t + 2) * kstep; const char* b2 = last ? nB : cB + (size_t)(t + 2) * kstep;
            const char* a3 = a2 + kstep; const char* b3 = b2 + kstep;
            if (last && has_next) S.a_ready(nxt);
            if constexpr (SP2) {
            PG8_LDB(B0, 0, 0); PG8_LDB(B1, 0, 1); PG8_SCHED; PG8_LDA(At, 0, 0); PG8_STAGE(PG8_SA(1, 1), a1 + hstep, voffA);
            PG8_WAIT_V(8); PG8_WAIT_L(0); PG8_BAR; PG8_MMA(0, 0, At, B0); PG8_MMA(0, 1, At, B1); PG8_BAR; PG8_SCHED;
            PG8_LDA(At, 0, 1); PG8_STAGE(PG8_SB(0, 0), b2, voffB); PG8_STAGE(PG8_SB(0, 1), b2 + hstep, voffB); PG8_STAGE(PG8_SA(0, 0), a2, voffA);
            PG8_WAIT_V(8); PG8_WAIT_L(0); PG8_BAR; PG8_MMA(1, 0, At, B0); PG8_MMA(1, 1, At, B1); PG8_BAR; PG8_SCHED;
            PG8_LDB(B0, 1, 0); PG8_LDB(B1, 1, 1); PG8_SCHED; PG8_LDA(At, 1, 0); PG8_STAGE(PG8_SA(0, 1), a2 + hstep, voffA);
            PG8_WAIT_V(8); PG8_WAIT_L(0); PG8_BAR; PG8_MMA(0, 0, At, B0); PG8_MMA(0, 1, At, B1); PG8_BAR; PG8_SCHED;
            PG8_LDA(At, 1, 1); PG8_STAGE(PG8_SB(1, 0), b3, voffB); PG8_STAGE(PG8_SB(1, 1), b3 + hstep, voffB); PG8_STAGE(PG8_SA(1, 0), a3, voffA);
            PG8_WAIT_V(8); PG8_WAIT_L(0); PG8_BAR; PG8_MMA(1, 0, At, B0); PG8_MMA(1, 1, At, B1); PG8_BAR; PG8_SCHED;
            } else {
            PG8_LDB(B0, 0, 0); PG8_SCHED; PG8_LDA(At, 0, 0); PG8_STAGE(PG8_SA(1, 1), a1 + hstep, voffA);
            PG8_WAIT_L(8); PG8_BAR; PG8_WAIT_L(0); PG8_MMA(0, 0, At, B0); PG8_BAR; PG8_SCHED;
            PG8_LDB(B1, 0, 1); PG8_STAGE(PG8_SB(0, 0), b2, voffB);
            PG8_BAR; PG8_WAIT_L(0); PG8_MMA(0, 1, At, B1); PG8_BAR;
            PG8_LDA(At, 0, 1); PG8_STAGE(PG8_SA(0, 0), a2, voffA);
            PG8_BAR; PG8_WAIT_L(0); PG8_MMA(1, 0, At, B0); PG8_BAR; PG8_SCHED;
            PG8_STAGE(PG8_SB(0, 1), b2 + hstep, voffB);
            PG8_WAIT_V(6); PG8_BAR; PG8_MMA(1, 1, At, B1); PG8_BAR;
            PG8_LDB(B0, 1, 0); PG8_SCHED; PG8_LDA(At, 1, 0); PG8_STAGE(PG8_SA(0, 1), a2 + hstep, voffA);
            PG8_WAIT_L(8); PG8_BAR; PG8_WAIT_L(0); PG8_MMA(0, 0, At, B0); PG8_BAR; PG8_SCHED;
            PG8_LDB(B1, 1, 1); PG8_STAGE(PG8_SB(1, 0), b3, voffB);
            PG8_BAR; PG8_WAIT_L(0); PG8_MMA(0, 1, At, B1); PG8_BAR;
            PG8_LDA(At, 1, 1); PG8_STAGE(PG8_SA(1, 0), a3, voffA);
            PG8_BAR; PG8_WAIT_L(0); PG8_MMA(1, 0, At, B0); PG8_BAR; PG8_SCHED;
            PG8_STAGE(PG8_SB(1, 1), b3 + hstep, voffB);
            PG8_WAIT_V(6); PG8_BAR; PG8_MMA(1, 1, At, B1); PG8_BAR;
            }
        }
        if constexpr (ALIGN_EPI) { if (wr == 0) PG8_BAR; }
        if constexpr (!Epi::AFTER_DRAIN) { E(acc, cur, wr, wc, fr, fq); S.done(cur); }
        if (!has_next) break;
#pragma unroll
        for (int a = 0; a < 2; ++a)
#pragma unroll
            for (int b = 0; b < 2; ++b)
#pragma unroll
                for (int m = 0; m < 4; ++m)
#pragma unroll
                    for (int n = 0; n < 2; ++n) acc[a][b][m][n] = (f32x4){0.f, 0.f, 0.f, 0.f};
        cur = nxt; cA = nA; cB = nB; ++ui;
        if constexpr (ALIGN_EPI) { if (wr == 1) PG8_BAR; }
    }
    PG8_WAIT_V(0);
    if constexpr (!ALIGN_EPI) { if (wr == 0) PG8_BAR; }
    PG8_BAR;
    if constexpr (Epi::AFTER_DRAIN) { E.fused(acc, cur, wr, wc, fr, fq, lds, wid, lane); S.done(cur); }
#undef PG8_SA
#undef PG8_SB
#undef PG8_STAGE
#undef PG8_LDA
#undef PG8_LDB
#undef PG8_MMA
#undef PG8_WAIT_V
#undef PG8_WAIT_L
#undef PG8_BAR
#undef PG8_SCHED
}
}
#define LAS __attribute__((address_space(3)))
typedef unsigned short bf16;
typedef float f32x4 __attribute__((ext_vector_type(4)));
typedef float f32x8 __attribute__((ext_vector_type(8)));
typedef short bf16x8 __attribute__((ext_vector_type(8)));
typedef unsigned u32x4v __attribute__((ext_vector_type(4)));
typedef unsigned u32x2v __attribute__((ext_vector_type(2)));
constexpr int NB = 8, T = 2048, D = 2048, M = NB * T, FF = 5632, PW = 7168, NINW = 6920;
constexpr int GDN_BASE = 1856, DIFF_BASE = 3968;
constexpr int NWAVES = 8, NTHR = 512;
constexpr size_t MiB = 1u << 20;
constexpr size_t WS_CTL = 0, WS_WIN = 1 * MiB, WS_AT = 1 * MiB  , WS_GL = 9 * MiB, WS_WOUT = 29 * MiB, WS_WFI = 37 * MiB, WS_WFO = 81 * MiB, WS_LORA = 103 * MiB, WS_H = 104 * MiB,
                 WS_P = 168 * MiB, WS_MIXED = 392 * MiB, WS_VFIRST = 456 * MiB, WS_RW = 472 * MiB, WS_WR0 = 600 * MiB, WS_WR1 = 632 * MiB, WS_V = 664 * MiB, WS_SC0 = 696 * MiB, WS_SC1 = 698 * MiB,
                 WS_END = 700 * MiB;
constexpr size_t RWSZ = (size_t)M * 512;
constexpr int LDS_BYTES = 147456;
#define MFMA16(a, b, c) __builtin_amdgcn_mfma_f32_16x16x32_bf16(a, b, c, 0, 0, 0)

struct Args { const float* in[33]; float* out; unsigned char* ws; int ph_lo, ph_hi; };

__device__ __forceinline__ float bf2f(unsigned h) { return __builtin_bit_cast(float, h << 16); }
typedef float f32x2_t __attribute__((ext_vector_type(2))); typedef __bf16 bf16x2_t __attribute__((ext_vector_type(2)));
__device__ __forceinline__ unsigned pk2(float lo, float hi) { f32x2_t v = {lo, hi}; bf16x2_t b = __builtin_convertvector(v, bf16x2_t); return __builtin_bit_cast(unsigned, b); }
__device__ __forceinline__ unsigned f2bf(float f) { return pk2(f, f) & 0xffffu; }
__device__ __forceinline__ float bflo(unsigned w) { return __builtin_bit_cast(float, w << 16); }
__device__ __forceinline__ float bfhi(unsigned w) { return __builtin_bit_cast(float, w & 0xffff0000u); }
__device__ __forceinline__ float sigmoidf_(float x) { return __builtin_amdgcn_rcpf(1.0f + __expf(-x)); }
__device__ __forceinline__ float softplusf_(float x) { return fmaxf(x, 0.f) + __logf(1.0f + __expf(-fabsf(x))); }
__device__ __forceinline__ float tanhf_(float x) { const float e = __expf(-2.0f * fabsf(x)); const float t = (1.0f - e) * __builtin_amdgcn_rcpf(1.0f + e); return x < 0.f ? -t : t; }
__device__ __forceinline__ float wave_sum(float v) {
#pragma unroll
    for (int o = 1; o < 64; o <<= 1) v += __shfl_xor(v, o);
    return v;
}
__device__ __forceinline__ void unpack8(u32x4v w, float* f) { f[0] = bflo(w.x); f[1] = bfhi(w.x); f[2] = bflo(w.y); f[3] = bfhi(w.y); f[4] = bflo(w.z); f[5] = bfhi(w.z); f[6] = bflo(w.w); f[7] = bfhi(w.w); }
#define ROR_ADD(x, n) x += __builtin_bit_cast(float, __builtin_amdgcn_update_dpp(0, __builtin_bit_cast(int, x), 0x120 + (n), 0xf, 0xf, false))
#define BAR_LDS() do { asm volatile("s_waitcnt lgkmcnt(0)" ::: "memory"); __builtin_amdgcn_s_barrier(); asm volatile("" ::: "memory"); } while (0)

__device__ __forceinline__ int src_col(int mode, int n) {
    if (mode == 0) return n;
    if (mode == 2) { const int g = n >> 3, e = n & 7; return (e < 4) ? 4 * g + e : FF + 4 * g + (e - 4); }
    if (n < 1792) return n;
    if (n < 1824) return -2;
    if (n < GDN_BASE) return -1;
    if (n < GDN_BASE + 2056) return 1792 + (n - GDN_BASE);
    if (n < DIFF_BASE) return -1;
    if (n < DIFF_BASE + 3072) return 3848 + (n - DIFF_BASE);
    return -1;
}
__device__ __forceinline__ void transpose_item(const float* W, int K, int N, bf16* WT, LAS float* scr, int item, int nblk, int lane, int mode, const float* W2) {
    const int kb = item / nblk, nb = item % nblk, k0 = 64 * kb, n0 = 128 * nb;
    const int c32 = lane & 31, nn = n0 + 4 * c32;
    const int sc = src_col(mode, nn);
    f32x4 vals[32];
    {
        const bool useW = sc >= 0, use2 = (sc == -2) && (W2 != nullptr);
        const float* pl = useW ? W + (size_t)(k0 + (lane >> 5)) * N + sc : (use2 ? W2 + (size_t)(k0 + (lane >> 5)) * 32 + (nn - 1792) : W);
        const size_t step = useW ? (size_t)2 * N : (use2 ? 64 : 0);
#pragma unroll
        for (int i = 0; i < 32; ++i) { f32x4 v = *(const f32x4*)pl; pl += step; if (!(useW || use2)) v = (f32x4){0.f, 0.f, 0.f, 0.f}; vals[i] = v; }
    }
#pragma unroll
    for (int pass = 0; pass < 2; ++pass) {
        if ((c32 >> 4) == pass) {
            const int cc = 4 * (c32 & 15);
#pragma unroll
            for (int i = 0; i < 32; ++i) { LAS float* d = scr + (2 * i + (lane >> 5)) * 65 + cc; d[0] = vals[i].x; d[1] = vals[i].y; d[2] = vals[i].z; d[3] = vals[i].w; }
        }
        asm volatile("s_waitcnt lgkmcnt(0)" ::: "memory");
        const int c = lane & 7;
#pragma unroll
        for (int j = 0; j < 8; ++j) { const int n = (lane >> 3) + 8 * j; const LAS float* s = scr + (8 * c) * 65 + n;
            u32x4v o; o.x = pk2(s[0 * 65], s[1 * 65]); o.y = pk2(s[2 * 65], s[3 * 65]); o.z = pk2(s[4 * 65], s[5 * 65]); o.w = pk2(s[6 * 65], s[7 * 65]);
            *(u32x4v*)(WT + (size_t)(n0 + 64 * pass + n) * K + k0 + 8 * c) = o; }
        asm volatile("s_waitcnt lgkmcnt(0)" ::: "memory");
    }
}
__device__ __forceinline__ void norm_rows(const float* x, const float* w, bf16* H, int gw, int ngw, int lane) {
    for (int m0 = gw; m0 < M; m0 += 4 * ngw) {
        f32x4 v[4][8]; float s[4];
#pragma unroll
        for (int q = 0; q < 4; ++q) { const int m = (m0 + q * ngw < M) ? m0 + q * ngw : m0; const f32x4* xr = (const f32x4*)(x + (size_t)m * D) + lane;
#pragma unroll
            for (int j = 0; j < 8; ++j) v[q][j] = xr[64 * j]; }
#pragma unroll
        for (int q = 0; q < 4; ++q) { float a = 0.f;
#pragma unroll
            for (int j = 0; j < 8; ++j) a += (v[q][j].x * v[q][j].x + v[q][j].y * v[q][j].y) + (v[q][j].z * v[q][j].z + v[q][j].w * v[q][j].w);
            s[q] = rsqrtf(wave_sum(a) * (1.f / D) + 1e-6f); }
#pragma unroll
        for (int j = 0; j < 8; ++j) { const f32x4 ww = ((const f32x4*)w)[lane + 64 * j];
#pragma unroll
            for (int q = 0; q < 4; ++q) { const int m = m0 + q * ngw;
                if (m < M) { u32x2v o; o.x = pk2(v[q][j].x * s[q] * ww.x, v[q][j].y * s[q] * ww.y); o.y = pk2(v[q][j].z * s[q] * ww.z, v[q][j].w * s[q] * ww.w); ((u32x2v*)(H + (size_t)m * D) + lane)[64 * j] = o; } } }
    }
}
__device__ __forceinline__ void prep_phase(const Args& c, int l, LAS unsigned char* lds, int vcu, int G) {
    int tid_ = threadIdx.x; asm volatile("" : "+v"(tid_)); unsigned char* wsl = c.ws; asm volatile("" : "+s"(wsl)); int z_ = 0; asm volatile("" : "+s"(z_));
    const int tid = tid_, lane = tid & 63, wave = __builtin_amdgcn_readfirstlane(tid >> 6);
    LAS float* scr = (LAS float*)(lds + wave * 16640);
    const int gw = vcu * NWAVES + wave, NGW = G * NWAVES;
    constexpr int I_IN = (D / 64) * (PW / 128), I_OUT = (D / 64) * (D / 128), I_FI = (D / 64) * (2 * FF / 128), I_FO = (FF / 64) * (D / 128);
    const float* w_in = c.in[2 + z_] + (size_t)l * D * NINW; const float* w_vres = (l > 0) ? c.in[3 + z_] + (size_t)(l - 1) * D * 32 : nullptr;
    const float* w_out = c.in[29 + z_] + (size_t)l * D * D; const float* w_fi = c.in[31 + z_] + (size_t)l * D * 2 * FF; const float* w_fo = c.in[32 + z_] + (size_t)l * FF * D;
    for (int it = gw; it < I_IN + I_OUT + I_FI + I_FO; it += NGW) {
        int r = it;
        if (r < I_IN) { transpose_item(w_in, D, NINW, ((bf16*)(wsl + WS_WIN)), scr, r, PW / 128, lane, 1, w_vres); continue; } r -= I_IN;
        if (r < I_OUT) { transpose_item(w_out, D, D, ((bf16*)(wsl + WS_WOUT)), scr, r, D / 128, lane, 0, nullptr); continue; } r -= I_OUT;
        if (r < I_FI) { transpose_item(w_fi, D, 2 * FF, ((bf16*)(wsl + WS_WFI)), scr, r, 2 * FF / 128, lane, 2, nullptr); continue; } r -= I_FI;
        transpose_item(w_fo, FF, D, ((bf16*)(wsl + WS_WFO)), scr, r, D / 128, lane, 0, nullptr);
    }
    for (int i = (vcu * NTHR + tid); i < 512 * 288; i += G * NTHR) { const int ch = i / 288, k = i % 288; float v;
        if (k < 64) v = c.in[7 + z_][(size_t)l * 64 * 512 + k * 512 + ch]; else if (k < 128) v = c.in[9 + z_][(size_t)l * 64 * 512 + (k - 64) * 512 + ch];
        else if (k < 256) v = c.in[10 + z_][(size_t)l * 128 * 512 + (k - 128) * 512 + ch]; else v = (l > 0) ? c.in[12 + z_][(size_t)(l - 1) * 32 * 512 + (k - 256) * 512 + ch] : 0.f;
        ((bf16*)(wsl + WS_LORA))[i] = (bf16)f2bf(v); }
    norm_rows(l == 0 ? c.in[0 + z_] : c.out, c.in[1 + z_] + (size_t)l * D, ((bf16*)(wsl + WS_H)), gw, NGW, lane);
}
__device__ __forceinline__ void rwkv_prep_unit(const Args& c, int u, int l, LAS unsigned char* lds) {
    int tid_ = threadIdx.x; asm volatile("" : "+v"(tid_)); unsigned char* wsl = c.ws; asm volatile("" : "+s"(wsl)); int z_ = 0; asm volatile("" : "+s"(z_));
    float* rwb_ = (l == 0) ? c.out : (float*)(wsl + WS_RW); float* rwr_ = (float*)(wsl + (l == 0 ? WS_WR0 : WS_WR1)); float* rsc_ = (float*)(wsl + (l == 0 ? WS_SC0 : WS_SC1));
    const int tid = tid_, lane = tid & 63, w = __builtin_amdgcn_readfirstlane(tid >> 6), r = lane & 15, q4 = lane >> 4;
    const int tok0 = u * 16;
    LAS bf16* xs = (LAS bf16*)lds;
    const bf16* P = ((bf16*)(wsl + WS_P));
    const float* mu = c.in[4 + z_] + (size_t)l * 1792;
    __syncthreads();
#pragma unroll
    for (int it = 0; it < 9; ++it) {
        const int idx = tid + it * NTHR;
        const int t = idx / 288, j = idx % 288, tok = tok0 + t;
        const bool use = (j < 256) || (l > 0);
        const int col = (j < 256) ? 1536 + j : 1792 + (j - 256);
        const float m_ = (j < 256) ? mu[1536 + j] : ((l > 0) ? c.in[5 + z_][(size_t)(l - 1) * 32 + (j - 256)] : 0.f);
        const bool hp = (tok & (T - 1)) != 0;
        const float cur = bf2f(P[(size_t)tok * PW + col]);
        const float pv = bf2f(P[(size_t)(hp ? tok - 1 : tok) * PW + col]);
        const float prev = hp ? pv : 0.f;
        float x = cur + (prev - cur) * m_;
        const float xt = tanhf_(x), xs_ = sigmoidf_(x);
        x = (j < 64) ? xt : ((j >= 128 && j < 256) ? xs_ : x);
        xs[t * 296 + j] = (bf16)f2bf(use ? x : 0.f);
    }
    __syncthreads();
    f32x4 aw[4], aa[4], ag[4], av[4];
#pragma unroll
    for (int jb = 0; jb < 4; ++jb) { aw[jb] = (f32x4){0.f, 0.f, 0.f, 0.f}; aa[jb] = aw[jb]; ag[jb] = aw[jb]; av[jb] = aw[jb]; }
    const bf16* Lt = ((bf16*)(wsl + WS_LORA)) + (size_t)(64 * w + r) * 288 + q4 * 8;
#pragma unroll
    for (int ks = 0; ks < 9; ++ks) {
        const bf16x8 af = *(const LAS bf16x8*)(xs + r * 296 + ks * 32 + q4 * 8);
#pragma unroll
        for (int jb = 0; jb < 4; ++jb) {
            const bf16x8 bf = *(const bf16x8*)(Lt + (size_t)jb * 16 * 288 + ks * 32);
            if (ks < 2) aw[jb] = MFMA16(af, bf, aw[jb]); else if (ks < 4) aa[jb] = MFMA16(af, bf, aa[jb]); else if (ks < 8) ag[jb] = MFMA16(af, bf, ag[jb]); else av[jb] = MFMA16(af, bf, av[jb]);
        }
    }
    float rr[4][4], k2[4][4], vv[4][4], dec[4][4], asg[4][4], kkr[4][4], rkv[4];
#pragma unroll
    for (int jb = 0; jb < 4; ++jb) {
        const int ch = 64 * w + 16 * jb + r;
        const float mu_r = mu[ch], mu_k = mu[512 + ch], mu_v = mu[1024 + ch];
        const float w0 = c.in[6 + z_][l * 512 + ch], a0 = c.in[8 + z_][l * 512 + ch], kk_ = c.in[13 + z_][l * 512 + ch], ka_ = c.in[14 + z_][l * 512 + ch];
        rkv[jb] = c.in[15 + z_][l * 512 + ch];
        const float v0 = (l > 0) ? c.in[11 + z_][(l - 1) * 512 + ch] : 0.f;
#pragma unroll
        for (int e = 0; e < 4; ++e) {
            const int tok = tok0 + 4 * q4 + e; const bool hp = (tok & (T - 1)) != 0;
            const bf16* pr = P + (size_t)tok * PW + ch;
            const float cr = bf2f(pr[0]), ck = bf2f(pr[512]), cv = bf2f(pr[1024]);
            const bf16* pp = hp ? pr - PW : pr;
            const float lr_ = bf2f(pp[0]), lk_ = bf2f(pp[512]), lv_ = bf2f(pp[1024]);
            const float pr_ = hp ? lr_ : 0.f, pk_ = hp ? lk_ : 0.f, pv_ = hp ? lv_ : 0.f;
            const float r_ = cr + (pr_ - cr) * mu_r, k_ = ck + (pk_ - ck) * mu_k; float v_ = cv + (pv_ - cv) * mu_v;
            const float wl = -softplusf_(-(w0 + aw[jb][e])) - 0.5f;
            const float d_ = __expf(-__expf(wl));
            const float a_ = sigmoidf_(a0 + aa[jb][e]);
            if (l == 0) ((bf16*)(wsl + WS_VFIRST))[(size_t)tok * 512 + ch] = (bf16)f2bf(v_);
            else { const float vf = bf2f(((bf16*)(wsl + WS_VFIRST))[(size_t)tok * 512 + ch]); v_ = v_ + (vf - v_) * sigmoidf_(v0 + av[jb][e]); }
            rr[jb][e] = r_; vv[jb][e] = v_; dec[jb][e] = d_; asg[jb][e] = a_;
            kkr[jb][e] = k_ * kk_; k2[jb][e] = k_ * (1.0f + (a_ - 1.0f) * ka_);
            ((bf16*)(wsl + WS_MIXED))[(size_t)tok * 2048 + ch] = (bf16)f2bf(ag[jb][e]);
        }
    }
    float kkn[4][4], bpn[4][4];
#pragma unroll
    for (int e = 0; e < 4; ++e) {
        const int tok = tok0 + 4 * q4 + e;
        float ss = 0.f;
#pragma unroll
        for (int jb = 0; jb < 4; ++jb) ss += kkr[jb][e] * kkr[jb][e];
        ss += __shfl_xor(ss, 1); ss += __shfl_xor(ss, 2); ss += __shfl_xor(ss, 4); ss += __shfl_xor(ss, 8);
        const float rn = rsqrtf(ss + 1e-6f);
        float bs = 0.f;
#pragma unroll
        for (int jb = 0; jb < 4; ++jb) {
            const int ch = 64 * w + 16 * jb + r;
            kkn[jb][e] = kkr[jb][e] * rn; bpn[jb][e] = kkn[jb][e] * asg[jb][e];
            ((float*)(wsl + WS_V))[(size_t)tok * 512 + ch] = vv[jb][e];
            bs += rr[jb][e] * k2[jb][e] * rkv[jb];
        }
#pragma unroll
        for (int o = 1; o < 16; o <<= 1) bs += __shfl_xor(bs, o);
        if (r == 0) *(f32x4*)(rsc_ + ((size_t)tok * 8 + w) * 4) = (f32x4){0.f, 0.f, bs, 0.f};
    }
    const int cq = u * 8 + w;
    bf16* AHp = (bf16*)(wsl + WS_RW) + (size_t)cq * 1024; bf16* RHp = (bf16*)(wsl + WS_RW + 16 * MiB) + (size_t)cq * 1024;
    bf16* BKp = (bf16*)(wsl + WS_RW + 32 * MiB) + (size_t)cq * 2048; float* NMp = (float*)(wsl + WS_RW + 64 * MiB) + (size_t)cq * 1024;
    float* G15p = (float*)(wsl + WS_RW + 96 * MiB) + (size_t)cq * 64;
    LAS bf16* nst = (LAS bf16*)(lds + 16384 + w * 14336);
    LAS bf16* bkl = nst + 4608;
#pragma unroll
    for (int jb = 0; jb < 4; ++jb) {
        const int j = 16 * jb + r;
        const float g0 = dec[jb][0], g1 = g0 * dec[jb][1], g2 = g1 * dec[jb][2], g3 = g2 * dec[jb][3];
        const float t0 = __shfl(g3, r), t1 = __shfl(g3, r + 16), t2 = __shfl(g3, r + 32), t3 = __shfl(g3, r + 48);
        const float pre = (q4 == 0) ? 1.0f : (q4 == 1) ? t0 : (q4 == 2) ? t0 * t1 : t0 * t1 * t2;
        const float g15 = (t0 * t1) * (t2 * t3);
        const float gam[4] = {pre * g0, pre * g1, pre * g2, pre * g3};
        const float gpv[4] = {pre, pre * g0, pre * g1, pre * g2};
        if (q4 == 0) G15p[j] = g15;
#pragma unroll
        for (int e = 0; e < 4; ++e) {
            const int t = 4 * q4 + e;
            const float ah = -kkn[jb][e] * gpv[e], rh = rr[jb][e] * gam[e], inv = __builtin_amdgcn_rcpf(gam[e]);
            const float bh = bpn[jb][e] * inv, kh = k2[jb][e] * inv;
            bkl[j * 40 + t] = (bf16)f2bf(bh * g15); bkl[j * 40 + 16 + t] = (bf16)f2bf(kh * g15);
            nst[t * 72 + j] = (bf16)f2bf(bh); nst[1152 + t * 72 + j] = (bf16)f2bf(kh); nst[2304 + t * 72 + j] = (bf16)f2bf(ah); nst[3456 + t * 72 + j] = (bf16)f2bf(rh);
        }
    }
    asm volatile("" ::: "memory");
#pragma unroll
    for (int i = 0; i < 2; ++i) { const int idx = lane + 64 * i, t = idx >> 3, c8 = idx & 7;
        *(u32x4v*)(AHp + t * 64 + c8 * 8) = *(const LAS u32x4v*)(nst + 2304 + t * 72 + c8 * 8);
        *(u32x4v*)(RHp + t * 64 + c8 * 8) = *(const LAS u32x4v*)(nst + 3456 + t * 72 + c8 * 8); }
#pragma unroll
    for (int i = 0; i < 4; ++i) { const int idx = lane + 64 * i, j = idx >> 2, c8 = idx & 3;
        *(u32x4v*)(BKp + j * 32 + c8 * 8) = *(const LAS u32x4v*)(bkl + j * 40 + c8 * 8); }
#pragma unroll
    for (int m = 0; m < 4; ++m) {
        f32x4 acc = (f32x4){0.f, 0.f, 0.f, 0.f};
#pragma unroll
        for (int ks = 0; ks < 2; ++ks) {
            const bf16x8 fa = *(const LAS bf16x8*)(nst + (m & 1) * 1152 + r * 72 + ks * 32 + q4 * 8);
            const bf16x8 fb = *(const LAS bf16x8*)(nst + (2 + (m >> 1)) * 1152 + r * 72 + ks * 32 + q4 * 8);
            acc = MFMA16(fa, fb, acc);
        }
#pragma unroll
        for (int e = 0; e < 4; ++e) { const int sidx = 4 * q4 + e; const bool keep = (m < 2) ? (sidx < r) : (sidx <= r); if (!keep) acc[e] = 0.f; }
        if (m == 0) {
#pragma unroll
            for (int e = 0; e < 4; ++e) NMp[(4 * q4 + e) * 16 + r] = acc[e];
        }
        if (m == 1) { u32x2v o; o.x = pk2(acc[0], acc[1]); o.y = pk2(acc[2], acc[3]); *(LAS u32x2v*)(nst + 2304 + r * 24 + 4 * q4) = o; }
        if (m >= 2) { u32x2v o; o.x = pk2(acc[0], acc[1]); o.y = pk2(acc[2], acc[3]); *(u32x2v*)((bf16*)(wsl + WS_RW + 98 * MiB) + (size_t)cq * 512 + r * 32 + (m - 2) * 16 + 4 * q4) = o; }
    }
    asm volatile("" ::: "memory");
    {
        bf16* VBp = (bf16*)(wsl + WS_WR1) + (size_t)cq * 1024; bf16* VNp = (bf16*)(wsl + WS_WR0) + (size_t)cq * 1024;
#pragma unroll
        for (int jb = 0; jb < 4; ++jb) { u32x2v o; o.x = pk2(vv[jb][0], vv[jb][1]); o.y = pk2(vv[jb][2], vv[jb][3]);
            *(LAS u32x2v*)(nst + (16 * jb + r) * 24 + 4 * q4) = o; *(u32x2v*)(VBp + (16 * jb + r) * 16 + 4 * q4) = o; }
        asm volatile("" ::: "memory");
        const bf16x8 zf = (bf16x8){0, 0, 0, 0, 0, 0, 0, 0};
        const bf16x8 fn = (q4 < 2) ? *(const LAS bf16x8*)(nst + 2304 + r * 24 + q4 * 8) : zf;
#pragma unroll
        for (int ib = 0; ib < 4; ++ib) {
            const bf16x8 fv = (q4 < 2) ? *(const LAS bf16x8*)(nst + (16 * ib + r) * 24 + q4 * 8) : zf;
            const f32x4 acc = MFMA16(fv, fn, ((f32x4){0.f, 0.f, 0.f, 0.f}));
            u32x2v o; o.x = pk2(acc[0], acc[1]); o.y = pk2(acc[2], acc[3]); *(u32x2v*)(VNp + r * 64 + 16 * ib + 4 * q4) = o;
        }
    }
}
#define ROR_ADD_DUMMY 0
__device__ __forceinline__ float swap32_add(float x, float y) { asm("s_nop 1\n\tv_permlane32_swap_b32 %0, %1" : "+v"(x), "+v"(y)); return x + y; }
__device__ __forceinline__ float swap16_add(float x, float y) { asm("s_nop 1\n\tv_permlane16_swap_b32 %0, %1" : "+v"(x), "+v"(y)); return x + y; }
__device__ __forceinline__ float wave_sum_fast(float x) {
    ROR_ADD(x, 8); ROR_ADD(x, 4); ROR_ADD(x, 2); ROR_ADD(x, 1);
    float y = x; asm("" : "+v"(y)); x = swap16_add(x, y); y = x; asm("" : "+v"(y)); return swap32_add(x, y);
}
__device__ __forceinline__ void rwkv_scan(const Args& c, int bx, int l, LAS unsigned char* lds, bool dry) {
    int tid_ = threadIdx.x; asm volatile("" : "+v"(tid_)); unsigned char* wsl = c.ws; asm volatile("" : "+s"(wsl)); int z_ = 0; asm volatile("" : "+s"(z_));
    const int tid = tid_, L = tid & 63, w = __builtin_amdgcn_readfirstlane(tid >> 6), r = L & 15, q4 = L >> 4;
    const int hh = bx * 2 + (w >> 2), wq = w & 3, b = hh >> 3, h = hh & 7;
    LAS unsigned char* wl = lds + w * 5376;
    LAS bf16* St = (LAS bf16*)wl;
    LAS bf16* UVl = (LAS bf16*)wl;
    LAS float* Xl = (LAS float*)(wl + 2304);
    LAS float* Nl = (LAS float*)(wl + 3392);
    LAS float* Gl = (LAS float*)(wl + 4416);
    LAS bf16* XRl = (LAS bf16*)(wl + 4672);
    const bf16* AHb = (const bf16*)(wsl + WS_RW); const bf16* RHb = (const bf16*)(wsl + WS_RW + 16 * MiB); const bf16* BKb = (const bf16*)(wsl + WS_RW + 32 * MiB);
    const float* NMb = (const float*)(wsl + WS_RW + 64 * MiB); const bf16* NRb = (const bf16*)(wsl + WS_RW + 98 * MiB); const float* G15b = (const float*)(wsl + WS_RW + 96 * MiB);
    const bf16* VNb = (const bf16*)(wsl + WS_WR0); const bf16* VBb = (const bf16*)(wsl + WS_WR1);
    float* Yb = (float*)(wsl + WS_P) + (size_t)b * T * (PW / 2) + h * 64 + 16 * wq;
    f32x4 ST[4];
#pragma unroll
    for (int jb = 0; jb < 4; ++jb) ST[jb] = (f32x4){0.f, 0.f, 0.f, 0.f};
    bf16x8 pA[2], pR[2], pB[4], pNR; f32x4 pN; u32x2v pC; u32x4v pVB[2]; float pG;
    const int row = L & 15;
#define CQ_(N_) (((size_t)b * (T / 16) + (N_)) * 8 + h)
#define GLD(TY, UB, OFF) (*(const TY*)((const char*)(UB) + (OFF)))
    const unsigned oA = (unsigned)(r * 64 + q4 * 8) * 2u, oB = (unsigned)(r * 32 + q4 * 8) * 2u, oC = (unsigned)(r * 64 + 16 * wq + 4 * q4) * 2u, oN = (unsigned)L * 16u, oV = (unsigned)(16 * wq + row) * 32u, oG = (unsigned)L * 4u;
#define PF_AR(N_) do { const size_t cq_ = CQ_(N_); const bf16* ua = AHb + cq_ * 1024; const bf16* ur = RHb + cq_ * 1024; pA[0] = GLD(bf16x8, ua, oA); pA[1] = GLD(bf16x8, ua, oA + 64u); pR[0] = GLD(bf16x8, ur, oA); pR[1] = GLD(bf16x8, ur, oA + 64u); } while (0)
#define PF_BG(N_) do { const size_t cq_ = CQ_(N_); const bf16* ub = BKb + cq_ * 2048; _Pragma("unroll") for (int jb = 0; jb < 4; ++jb) pB[jb] = GLD(bf16x8, ub, oB + (unsigned)jb * 1024u); pG = GLD(float, G15b + cq_ * 64, oG); } while (0)
#define PF_N(N_) do { pN = GLD(f32x4, NMb + CQ_(N_) * 1024, oN); } while (0)
#define PF_NR(N_) do { pNR = GLD(bf16x8, NRb + CQ_(N_) * 512, oB); } while (0)
#define PF_C(N_) do { pC = GLD(u32x2v, VNb + CQ_(N_) * 1024, oC); } while (0)
#define PF_VB(N_) do { const bf16* uv = VBb + CQ_(N_) * 1024; pVB[0] = GLD(u32x4v, uv, oV); pVB[1] = GLD(u32x4v, uv, oV + 16u); } while (0)
#define FENCE() asm volatile("" ::: "memory")
    PF_AR(0); PF_C(0); PF_BG(0); PF_N(0); PF_NR(0); PF_VB(0);
    for (int n = 0; n < T / 16; ++n) {
        const bool more = (n + 1 < T / 16);
        *(LAS f32x4*)(Nl + L * 4) = pN;
        if (more) PF_N(n + 1);
#pragma unroll
        for (int jb = 0; jb < 4; ++jb) { u32x2v o; o.x = pk2(ST[jb][0], ST[jb][1]); o.y = pk2(ST[jb][2], ST[jb][3]); *(LAS u32x2v*)(St + r * 72 + 16 * jb + 4 * q4) = o; }
        FENCE();
        {
            f32x4 xa = (f32x4){bflo(pC.x), bfhi(pC.x), bflo(pC.y), bfhi(pC.y)}, xr = (f32x4){0.f, 0.f, 0.f, 0.f};
#pragma unroll
            for (int ks = 0; ks < 2; ++ks) { const bf16x8 fs = *(const LAS bf16x8*)(St + r * 72 + ks * 32 + q4 * 8); xa = MFMA16(fs, pA[ks], xa); xr = MFMA16(fs, pR[ks], xr); }
#pragma unroll
            for (int e = 0; e < 4; ++e) Xl[(4 * q4 + e) * 17 + r] = xa[e];
            u32x2v xo; xo.x = pk2(xr[0], xr[1]); xo.y = pk2(xr[2], xr[3]); *(LAS u32x2v*)(XRl + r * 20 + 4 * q4) = xo;
        }
        if (more) { PF_AR(n + 1); PF_C(n + 1); }
        FENCE();
        float uu[16];
        {
            const LAS float* xrow = Xl + row * 17;
#pragma unroll
            for (int t = 0; t < 16; ++t) uu[t] = xrow[t];
#pragma unroll
            for (int s0 = 0; s0 < 15; ++s0) {
#pragma unroll
                for (int t4 = (s0 + 1) & ~3; t4 < 16; t4 += 4) {
                    const f32x4 nab = *(const LAS f32x4*)(Nl + s0 * 16 + t4);
#pragma unroll
                    for (int e = 0; e < 4; ++e) if (t4 + e > s0) uu[t4 + e] += uu[s0] * nab[e];
                }
            }
        }
        FENCE();
#pragma unroll
        for (int g = 0; g < 2; ++g) { u32x4v o; o.x = pk2(uu[8 * g], uu[8 * g + 1]); o.y = pk2(uu[8 * g + 2], uu[8 * g + 3]); o.z = pk2(uu[8 * g + 4], uu[8 * g + 5]); o.w = pk2(uu[8 * g + 6], uu[8 * g + 7]); *(LAS u32x4v*)(UVl + row * 40 + 8 * g) = o;
            *(LAS u32x4v*)(UVl + row * 40 + 16 + 8 * g) = pVB[g]; }
        Gl[L] = pG;
        FENCE();
        {
            const bf16x8 fu = *(const LAS bf16x8*)(UVl + r * 40 + q4 * 8);
#pragma unroll
            for (int jb = 0; jb < 4; ++jb) { const f32x4 cG = *(const LAS f32x4*)(Gl + 16 * jb + 4 * q4); ST[jb] = MFMA16(pB[jb], fu, ST[jb] * cG); }
            const u32x2v xo = *(const LAS u32x2v*)(XRl + r * 20 + 4 * q4);
            const f32x4 yv = MFMA16(fu, pNR, ((f32x4){bflo(xo.x), bfhi(xo.x), bflo(xo.y), bfhi(xo.y)}));
            if (!dry) *(f32x4*)(Yb + ((size_t)n * 16 + r) * (PW / 2) + 4 * q4) = yv;
        }
        FENCE();
        if (more) { PF_BG(n + 1); PF_NR(n + 1); PF_VB(n + 1); }
    }
#undef CQ_
#undef GLD
#undef PF_AR
#undef PF_BG
#undef PF_N
#undef PF_NR
#undef PF_VB
#undef PF_C
#undef FENCE
}
__device__ __forceinline__ void rwkv_post(const Args& c, int l, int gw, int ngw) {
    int tid_ = threadIdx.x; asm volatile("" : "+v"(tid_)); unsigned char* wsl = c.ws; asm volatile("" : "+s"(wsl)); int z_ = 0; asm volatile("" : "+s"(z_));
    float* rwb_ = (l == 0) ? c.out : (float*)(wsl + WS_RW); float* rsc_ = (float*)(wsl + (l == 0 ? WS_SC0 : WS_SC1));
    const int i = tid_ & 63;
    const float* Y = (const float*)(wsl + WS_P); const float* V = (const float*)(wsl + WS_V); bf16* MX = (bf16*)(wsl + WS_MIXED);
    for (int it0 = gw; it0 < M * 8; it0 += 8 * ngw) {
        float y[8], vv[8], g[8], bs[8], lw[8], lb[8];
#pragma unroll
        for (int q = 0; q < 8; ++q) { const int it = it0 + q * ngw; const int itc = (it < M * 8) ? it : it0;
            const int h = itc & 7; const size_t tok = (size_t)(itc >> 3); const int ch = h * 64 + i;
            y[q] = Y[tok * (PW / 2) + ch]; vv[q] = V[tok * 512 + ch]; g[q] = bf2f(MX[tok * 2048 + ch]); bs[q] = rsc_[(tok * 8 + h) * 4 + 2];
            lw[q] = c.in[16 + z_][l * 512 + ch]; lb[q] = c.in[17 + z_][l * 512 + ch]; }
#pragma unroll
        for (int q = 0; q < 8; ++q) { const int it = it0 + q * ngw;
            const float mean = wave_sum_fast(y[q]) * (1.f / 64.f); const float d = y[q] - mean;
            const float var = wave_sum_fast(d * d) * (1.f / 64.f);
            const float yn = d * rsqrtf(var + 64e-5f) * lw[q] + lb[q];
            if (it < M * 8) { const int h = it & 7; const size_t tok = (size_t)(it >> 3); MX[tok * 2048 + h * 64 + i] = (bf16)f2bf((yn + bs[q] * vv[q]) * g[q]); } }
    }
}
__device__ __forceinline__ void gdn_prep_unit(const Args& c, int ug, int l, LAS unsigned char* lds) {
    int tid_ = threadIdx.x; asm volatile("" : "+v"(tid_)); unsigned char* wsl = c.ws; asm volatile("" : "+s"(wsl)); int z_ = 0; asm volatile("" : "+s"(z_));
    const int tid = tid_, lane = tid & 63, w = __builtin_amdgcn_readfirstlane(tid >> 6), r = lane & 15, q4 = lane >> 4;
    const int h = ug & 3, chunk = (ug >> 2) & 31, b = ug >> 7;
    const size_t tok0 = (size_t)b * T + 64 * chunk;
    LAS float* kf = (LAS float*)lds;
    LAS float* vf = kf + 64 * 132;
    LAS float* Mm = vf + 64 * 132;
    LAS float* gcs = Mm + 64 * 68;
    LAS float* bet = gcs + 64;
    LAS float* egs = bet + 64;
    LAS bf16* kb = (LAS bf16*)(egs + 64);
    LAS bf16* qb = kb + 64 * 136;
    const bf16* P = ((bf16*)(wsl + WS_P));
    const float* cw = c.in[18 + z_] + (size_t)l * 4 * 1536;
    __syncthreads();
    const int tl = tid >> 3, sub = tid & 7;
    float qv[16], kv[16];
    {
        float xv[16];
#pragma unroll
        for (int sec = 0; sec < 3; ++sec) {
            float acc[16];
#pragma unroll
            for (int e = 0; e < 16; ++e) acc[e] = 0.f;
#pragma unroll
            for (int i = 0; i < 4; ++i) {
                const int tin = 64 * chunk + tl - 3 + i; const bool ok = tin >= 0;
                const bf16* src = P + (tok0 + (ok ? tl - 3 + i : tl)) * PW + GDN_BASE + sec * 512 + h * 128 + sub * 16;
                const u32x4v a0 = *(const u32x4v*)src, a1 = *(const u32x4v*)(src + 8); float f[16]; unpack8(a0, f); unpack8(a1, f + 8);
                const f32x4* wp = (const f32x4*)(cw + i * 1536 + sec * 512 + h * 128 + sub * 16);
                const float okf = ok ? 1.f : 0.f;
#pragma unroll
                for (int e4 = 0; e4 < 4; ++e4) { const f32x4 wv = wp[e4];
                    acc[4 * e4] += f[4 * e4] * wv.x * okf; acc[4 * e4 + 1] += f[4 * e4 + 1] * wv.y * okf; acc[4 * e4 + 2] += f[4 * e4 + 2] * wv.z * okf; acc[4 * e4 + 3] += f[4 * e4 + 3] * wv.w * okf; }
            }
#pragma unroll
            for (int e = 0; e < 16; ++e) acc[e] = acc[e] * sigmoidf_(acc[e]);
            if (sec < 2) {
                float ss = 0.f;
#pragma unroll
                for (int e = 0; e < 16; ++e) ss += acc[e] * acc[e];
                ss += __shfl_xor(ss, 1); ss += __shfl_xor(ss, 2); ss += __shfl_xor(ss, 4);
                const float rn = rsqrtf(ss + 1e-6f) * (sec == 0 ? 0.08838834764831845f : 1.0f);
#pragma unroll
                for (int e = 0; e < 16; ++e) { if (sec == 0) qv[e] = acc[e] * rn; else kv[e] = acc[e] * rn; }
            } else {
#pragma unroll
                for (int e = 0; e < 16; ++e) xv[e] = acc[e];
            }
        }
#pragma unroll
        for (int e = 0; e < 16; e += 4) {
            *(LAS f32x4*)(kf + tl * 132 + sub * 16 + e) = (f32x4){kv[e], kv[e + 1], kv[e + 2], kv[e + 3]};
            *(LAS f32x4*)(vf + tl * 132 + sub * 16 + e) = (f32x4){xv[e], xv[e + 1], xv[e + 2], xv[e + 3]};
        }
        u32x4v o;
        o.x = pk2(kv[0], kv[1]); o.y = pk2(kv[2], kv[3]); o.z = pk2(kv[4], kv[5]); o.w = pk2(kv[6], kv[7]); *(LAS u32x4v*)(kb + tl * 136 + sub * 16) = o;
        o.x = pk2(kv[8], kv[9]); o.y = pk2(kv[10], kv[11]); o.z = pk2(kv[12], kv[13]); o.w = pk2(kv[14], kv[15]); *(LAS u32x4v*)(kb + tl * 136 + sub * 16 + 8) = o;
        o.x = pk2(qv[0], qv[1]); o.y = pk2(qv[2], qv[3]); o.z = pk2(qv[4], qv[5]); o.w = pk2(qv[6], qv[7]); *(LAS u32x4v*)(qb + tl * 136 + sub * 16) = o;
        o.x = pk2(qv[8], qv[9]); o.y = pk2(qv[10], qv[11]); o.z = pk2(qv[12], qv[13]); o.w = pk2(qv[14], qv[15]); *(LAS u32x4v*)(qb + tl * 136 + sub * 16 + 8) = o;
        if (sub == 0) {
            const float a_ = bf2f(P[(tok0 + tl) * PW + GDN_BASE + 2048 + h]), b_ = bf2f(P[(tok0 + tl) * PW + GDN_BASE + 2052 + h]);
            bet[tl] = sigmoidf_(b_);
            gcs[tl] = -__expf(c.in[19 + z_][l * 4 + h]) * softplusf_(a_ + c.in[20 + z_][l * 4 + h]);
        }
    }
    __syncthreads();
    if (w == 0) {
        float x = gcs[lane];
#pragma unroll
        for (int o = 1; o < 64; o <<= 1) { const float y = __shfl_up(x, o); if (lane >= o) x += y; }
        gcs[lane] = x; egs[lane] = __expf(x);
    }
    __syncthreads();
    {
        const float eg = egs[tl], ek = __expf(gcs[63] - gcs[tl]);
        bf16* qd = ((bf16*)(wsl + WS_H + 32 * MiB)) + (size_t)ug * 8192 + tl * 128 + sub * 16;
        u32x4v o;
        o.x = pk2(qv[0] * eg, qv[1] * eg); o.y = pk2(qv[2] * eg, qv[3] * eg); o.z = pk2(qv[4] * eg, qv[5] * eg); o.w = pk2(qv[6] * eg, qv[7] * eg); *(u32x4v*)qd = o;
        o.x = pk2(qv[8] * eg, qv[9] * eg); o.y = pk2(qv[10] * eg, qv[11] * eg); o.z = pk2(qv[12] * eg, qv[13] * eg); o.w = pk2(qv[14] * eg, qv[15] * eg); *(u32x4v*)(qd + 8) = o;
        bf16* kd = ((bf16*)(wsl + WS_H + 48 * MiB)) + (size_t)ug * 8192 + (sub * 16) * 64 + tl;
#pragma unroll
        for (int e = 0; e < 16; ++e) kd[e * 64] = (bf16)f2bf(kv[e] * ek);
        if (tid == 0) (((float*)(wsl + WS_GL)))[ug] = egs[63];
    }
    {
        const int ib = w >> 1;
#pragma unroll
        for (int jj = 0; jj < 2; ++jj) {
            const int jb = 2 * (w & 1) + jj;
            f32x4 ckk = (f32x4){0.f, 0.f, 0.f, 0.f}, cqk = ckk;
#pragma unroll
            for (int ks = 0; ks < 4; ++ks) {
                const bf16x8 ak = *(const LAS bf16x8*)(kb + (16 * ib + r) * 136 + ks * 32 + q4 * 8);
                const bf16x8 aq = *(const LAS bf16x8*)(qb + (16 * ib + r) * 136 + ks * 32 + q4 * 8);
                const bf16x8 bk = *(const LAS bf16x8*)(kb + (16 * jb + r) * 136 + ks * 32 + q4 * 8);
                ckk = MFMA16(ak, bk, ckk); cqk = MFMA16(aq, bk, cqk);
            }
            const int j = 16 * jb + r; const float gj = gcs[j];
#pragma unroll
            for (int e = 0; e < 4; ++e) {
                const int i = 16 * ib + 4 * q4 + e;
                const float dcy = (i >= j) ? __expf(gcs[i] - gj) : 0.f;
                Mm[i * 68 + j] = (i > j) ? bet[i] * ckk[e] * dcy : 0.f;
                ((bf16*)(wsl + WS_AT))[(size_t)ug * 4096 + i * 64 + j] = (bf16)f2bf(cqk[e] * dcy);
            }
        }
    }
    __syncthreads();
    if (tid < 256) {
        const int col = tid & 127; const bool isw = tid >= 128;
        int vz = 0; asm volatile("" : "+v"(vz));
        const LAS float* Mz = Mm + vz; const LAS float* betz = bet + vz; const LAS float* egz = egs + vz;
        float x[64];
#pragma unroll
        for (int i = 0; i < 64; ++i) x[i] = isw ? kf[i * 132 + col] * betz[i] * egz[i] : vf[i * 132 + col] * betz[i];
#pragma unroll
        for (int i = 1; i < 64; ++i) {
            float s0 = x[i], s1 = 0.f, s2 = 0.f, s3 = 0.f;
#pragma unroll
            for (int m4 = 0; m4 < i; m4 += 4) {
                const f32x4 mv = *(const LAS f32x4*)(Mz + i * 68 + m4);
                s0 -= mv.x * x[m4];
                if (m4 + 1 < i) s1 -= mv.y * x[m4 + 1];
                if (m4 + 2 < i) s2 -= mv.z * x[m4 + 2];
                if (m4 + 3 < i) s3 -= mv.w * x[m4 + 3];
            }
            const float s = (s0 + s1) + (s2 + s3);
            x[i] = s;
        }
        if (!isw) {
            bf16* ut = ((bf16*)(wsl + WS_H)) + (size_t)ug * 8192 + col * 64;
#pragma unroll
            for (int i = 0; i < 64; i += 8) { u32x4v o; o.x = pk2(x[i], x[i + 1]); o.y = pk2(x[i + 2], x[i + 3]); o.z = pk2(x[i + 4], x[i + 5]); o.w = pk2(x[i + 6], x[i + 7]); *(u32x4v*)(ut + i) = o; }
        } else {
            bf16* gw = ((bf16*)(wsl + WS_H + 16 * MiB)) + (size_t)ug * 8192 + col;
#pragma unroll
            for (int i = 0; i < 64; ++i) gw[i * 128] = (bf16)f2bf(x[i]);
        }
    }
}
__device__ __forceinline__ void gdn_scan(const Args& c, int bh, int l, LAS unsigned char* lds) {
    int tid_ = threadIdx.x; asm volatile("" : "+v"(tid_)); unsigned char* wsl = c.ws; asm volatile("" : "+s"(wsl)); int z_ = 0; asm volatile("" : "+s"(z_));
    const int tid = tid_, lane = tid & 63, w = __builtin_amdgcn_readfirstlane(tid >> 6), r = lane & 15, q4 = lane >> 4;
    const int b = bh >> 2, h = bh & 3;
    LAS bf16* St = (LAS bf16*)lds;
    LAS bf16* VNt = St + 128 * 136;
    LAS bf16* Wl = VNt + 128 * 72;
    LAS bf16* Ql = Wl + 64 * 136;
    LAS bf16* Zl = Ql + 64 * 136;
    LAS bf16* Al = Zl + 64 * 136;
    LAS bf16* Kl = Al + 64 * 72;
    LAS float* red = (LAS float*)(Kl + 128 * 72);
    const int v = 16 * w + r;
    const float nw = c.in[21 + z_][l * 128 + v];
    const bf16* UTb = (const bf16*)(wsl + WS_H); const bf16* GWb = (const bf16*)(wsl + WS_H + 16 * MiB); const bf16* QDb = (const bf16*)(wsl + WS_H + 32 * MiB);
    const bf16* KDb = (const bf16*)(wsl + WS_H + 48 * MiB); const bf16* ATb = (const bf16*)(wsl + WS_AT); const float* GLb = (const float*)(wsl + WS_GL);
    const bf16* Pz = (const bf16*)(wsl + WS_P) + GDN_BASE + 1536 + h * 128;
    bf16* MX = (bf16*)(wsl + WS_MIXED) + 512 + h * 128;
    f32x4 S[8];
#pragma unroll
    for (int ib = 0; ib < 8; ++ib) S[ib] = (f32x4){0.f, 0.f, 0.f, 0.f};
    u32x4v pw[2], pq[2], pz[2], pk[2], pa; u32x2v pu[4]; float pgl;
    const int r16 = tid >> 4, c16 = tid & 15, r8 = tid >> 3, c8 = tid & 7;
#define GDN_PREFETCH(CH) do { const int ug_ = (b * 32 + (CH)) * 4 + h; const size_t t0_ = (size_t)b * T + 64 * (CH); \
        _Pragma("unroll") for (int i = 0; i < 2; ++i) { \
            pw[i] = *(const u32x4v*)(GWb + (size_t)ug_ * 8192 + (r16 + 32 * i) * 128 + c16 * 8); \
            pq[i] = *(const u32x4v*)(QDb + (size_t)ug_ * 8192 + (r16 + 32 * i) * 128 + c16 * 8); \
            pz[i] = *(const u32x4v*)(Pz + (t0_ + r16 + 32 * i) * PW + c16 * 8); \
            pk[i] = *(const u32x4v*)(KDb + (size_t)ug_ * 8192 + (r8 + 64 * i) * 64 + c8 * 8); } \
        pa = *(const u32x4v*)(ATb + (size_t)ug_ * 4096 + r8 * 64 + c8 * 8); \
        _Pragma("unroll") for (int tb = 0; tb < 4; ++tb) pu[tb] = *(const u32x2v*)(UTb + (size_t)ug_ * 8192 + v * 64 + 16 * tb + 4 * q4); \
        pgl = GLb[ug_]; } while (0)
    GDN_PREFETCH(0);
    for (int ch = 0; ch < 32; ++ch) {
        const size_t tok0 = (size_t)b * T + 64 * ch;
        __syncthreads();
#pragma unroll
        for (int i = 0; i < 2; ++i) {
            *(LAS u32x4v*)(Wl + (r16 + 32 * i) * 136 + c16 * 8) = pw[i]; *(LAS u32x4v*)(Ql + (r16 + 32 * i) * 136 + c16 * 8) = pq[i];
            *(LAS u32x4v*)(Zl + (r16 + 32 * i) * 136 + c16 * 8) = pz[i]; *(LAS u32x4v*)(Kl + (r8 + 64 * i) * 72 + c8 * 8) = pk[i];
        }
        *(LAS u32x4v*)(Al + r8 * 72 + c8 * 8) = pa;
        u32x2v uc[4];
#pragma unroll
        for (int tb = 0; tb < 4; ++tb) uc[tb] = pu[tb];
        const float gl = pgl;
#pragma unroll
        for (int ib = 0; ib < 8; ++ib) { u32x2v o; o.x = pk2(S[ib][0], S[ib][1]); o.y = pk2(S[ib][2], S[ib][3]); *(LAS u32x2v*)(St + v * 136 + 16 * ib + 4 * q4) = o; }
        if (ch + 1 < 32) GDN_PREFETCH(ch + 1);
        __syncthreads();
        f32x4 aW[4], aQ[4];
#pragma unroll
        for (int tb = 0; tb < 4; ++tb) { aW[tb] = (f32x4){0.f, 0.f, 0.f, 0.f}; aQ[tb] = aW[tb]; }
#pragma unroll
        for (int ks = 0; ks < 4; ++ks) {
            const bf16x8 bs = *(const LAS bf16x8*)(St + v * 136 + ks * 32 + q4 * 8);
#pragma unroll
            for (int tb = 0; tb < 4; ++tb) {
                const bf16x8 fw = *(const LAS bf16x8*)(Wl + (16 * tb + r) * 136 + ks * 32 + q4 * 8);
                const bf16x8 fq = *(const LAS bf16x8*)(Ql + (16 * tb + r) * 136 + ks * 32 + q4 * 8);
                aW[tb] = MFMA16(fw, bs, aW[tb]); aQ[tb] = MFMA16(fq, bs, aQ[tb]);
            }
        }
#pragma unroll
        for (int tb = 0; tb < 4; ++tb) {
            const float n0 = bflo(uc[tb].x) - aW[tb][0], n1 = bfhi(uc[tb].x) - aW[tb][1], n2 = bflo(uc[tb].y) - aW[tb][2], n3 = bfhi(uc[tb].y) - aW[tb][3];
            u32x2v o; o.x = pk2(n0, n1); o.y = pk2(n2, n3); *(LAS u32x2v*)(VNt + v * 72 + 16 * tb + 4 * q4) = o;
        }
        BAR_LDS();
#pragma unroll
        for (int ib = 0; ib < 8; ++ib) S[ib] = S[ib] * gl;
#pragma unroll
        for (int ks = 0; ks < 2; ++ks) {
            const bf16x8 bv = *(const LAS bf16x8*)(VNt + v * 72 + ks * 32 + q4 * 8);
#pragma unroll
            for (int tb = 0; tb < 4; ++tb) { const bf16x8 fa = *(const LAS bf16x8*)(Al + (16 * tb + r) * 72 + ks * 32 + q4 * 8); aQ[tb] = MFMA16(fa, bv, aQ[tb]); }
#pragma unroll
            for (int ib = 0; ib < 8; ++ib) { const bf16x8 fk = *(const LAS bf16x8*)(Kl + (16 * ib + r) * 72 + ks * 32 + q4 * 8); S[ib] = MFMA16(fk, bv, S[ib]); }
        }
#pragma unroll
        for (int tb = 0; tb < 4; ++tb)
#pragma unroll
            for (int e = 0; e < 4; ++e) {
                float ss = aQ[tb][e] * aQ[tb][e];
                ROR_ADD(ss, 8); ROR_ADD(ss, 4); ROR_ADD(ss, 2); ROR_ADD(ss, 1);
                if (r == 0) red[w * 64 + 16 * tb + 4 * q4 + e] = ss;
            }
        BAR_LDS();
#pragma unroll
        for (int tb = 0; tb < 4; ++tb)
#pragma unroll
            for (int e = 0; e < 4; ++e) {
                const int tk = 16 * tb + 4 * q4 + e; float tot = 0.f;
#pragma unroll
                for (int k = 0; k < 8; ++k) tot += red[k * 64 + tk];
                const float rstd = rsqrtf(tot * (1.f / 128.f) + 1e-6f);
                const float z = bf2f(Zl[tk * 136 + v]);
                MX[(tok0 + tk) * 2048 + v] = (bf16)f2bf(aQ[tb][e] * rstd * nw * z * sigmoidf_(z));
            }
    }
#undef GDN_PREFETCH
    __syncthreads();
}
__device__ __forceinline__ void attn_unit(const Args& c, int l, int b, int h, int qb, float lam, float lam_init, LAS unsigned char* lds) {
    int tid_ = threadIdx.x; asm volatile("" : "+v"(tid_)); unsigned char* wsl = c.ws; asm volatile("" : "+s"(wsl)); int z_ = 0; asm volatile("" : "+s"(z_));
    const int tid = tid_, lane = tid & 63, w = __builtin_amdgcn_readfirstlane(tid >> 6), r = lane & 15, q4 = lane >> 4;
    LAS bf16* Kt = (LAS bf16*)lds;
    LAS bf16* Vs = Kt + 128 * 136;
    const bf16* P = ((bf16*)(wsl + WS_P));
    const size_t seq0 = (size_t)b * T;
    const int QC = DIFF_BASE + h * 128, KC = DIFF_BASE + 1024 + h * 128, VC = DIFF_BASE + 2048 + h * 128;
    const float* qnw = c.in[22 + z_] + l * 64; const float* knw = c.in[23 + z_] + l * 64;
    const int skey = tid >> 3, part = tid & 7;
    u32x4v gk0[2], gk1[2], gv0[2], gv1[2];
#define ATT_FETCH(KT) do { _Pragma("unroll") for (int hh = 0; hh < 2; ++hh) { const bf16* krow = P + (seq0 + 128 * (KT) + 64 * hh + skey) * PW; \
        gk0[hh] = *(const u32x4v*)(krow + KC + part * 16); gk1[hh] = *(const u32x4v*)(krow + KC + part * 16 + 8); \
        gv0[hh] = *(const u32x4v*)(krow + VC + part * 16); gv1[hh] = *(const u32x4v*)(krow + VC + part * 16 + 8); } } while (0)
    ATT_FETCH(0);
    bf16x8 qf[2][2];
    {
        const bf16* qrow = P + (seq0 + 128 * qb + 16 * w + r) * PW + QC;
#pragma unroll
        for (int m = 0; m < 2; ++m) {
            float f[16];
            unpack8(*(const u32x4v*)(qrow + m * 64 + q4 * 8), f); unpack8(*(const u32x4v*)(qrow + m * 64 + 32 + q4 * 8), f + 8);
            float ss = 0.f;
#pragma unroll
            for (int e = 0; e < 16; ++e) ss += f[e] * f[e];
            ss += __shfl_xor(ss, 16); ss += __shfl_xor(ss, 32);
            const float sc = rsqrtf(ss * (1.f / 64.f) + 1e-6f) * (0.125f * 1.4426950408889634f);
#pragma unroll
            for (int ks = 0; ks < 2; ++ks) { u32x4v o; const float* g = f + 8 * ks; const float* wn = qnw + ks * 32 + q4 * 8;
                o.x = pk2(g[0] * sc * wn[0], g[1] * sc * wn[1]); o.y = pk2(g[2] * sc * wn[2], g[3] * sc * wn[3]); o.z = pk2(g[4] * sc * wn[4], g[5] * sc * wn[5]); o.w = pk2(g[6] * sc * wn[6], g[7] * sc * wn[7]);
                qf[m][ks] = __builtin_bit_cast(bf16x8, o); }
        }
    }
    f32x4 O[2][8];
#pragma unroll
    for (int m = 0; m < 2; ++m)
#pragma unroll
        for (int vb = 0; vb < 8; ++vb) O[m][vb] = (f32x4){0.f, 0.f, 0.f, 0.f};
    float mrow[2] = {-INFINITY, -INFINITY}, lrow[2] = {0.f, 0.f};
    const int NT = qb + 1;
    const float* kwp = knw + (part & 3) * 16;
    typedef short v4i16_t __attribute__((ext_vector_type(4)));
    const int r4 = (lane & 15) >> 2, c4 = lane & 3;
    for (int kt = 0; kt < NT; ++kt) {
        __syncthreads();
#pragma unroll
        for (int hh = 0; hh < 2; ++hh) {
            const int kr = skey + 64 * hh;
            float f[16]; unpack8(gk0[hh], f); unpack8(gk1[hh], f + 8);
            float kw[16];
#pragma unroll
            for (int e4 = 0; e4 < 4; ++e4) { const f32x4 t4 = ((const f32x4*)kwp)[e4]; kw[4 * e4] = t4.x; kw[4 * e4 + 1] = t4.y; kw[4 * e4 + 2] = t4.z; kw[4 * e4 + 3] = t4.w; }
            float ss = 0.f;
#pragma unroll
            for (int e = 0; e < 16; ++e) ss += f[e] * f[e];
            ss += __shfl_xor(ss, 1); ss += __shfl_xor(ss, 2);
            const float sc = rsqrtf(ss * (1.f / 64.f) + 1e-6f);
            u32x4v o;
            o.x = pk2(f[0] * sc * kw[0], f[1] * sc * kw[1]); o.y = pk2(f[2] * sc * kw[2], f[3] * sc * kw[3]); o.z = pk2(f[4] * sc * kw[4], f[5] * sc * kw[5]); o.w = pk2(f[6] * sc * kw[6], f[7] * sc * kw[7]);
            *(LAS u32x4v*)(Kt + kr * 136 + part * 16) = o;
            o.x = pk2(f[8] * sc * kw[8], f[9] * sc * kw[9]); o.y = pk2(f[10] * sc * kw[10], f[11] * sc * kw[11]); o.z = pk2(f[12] * sc * kw[12], f[13] * sc * kw[13]); o.w = pk2(f[14] * sc * kw[14], f[15] * sc * kw[15]);
            *(LAS u32x4v*)(Kt + kr * 136 + part * 16 + 8) = o;
            *(LAS u32x4v*)(Vs + kr * 136 + part * 16) = gv0[hh]; *(LAS u32x4v*)(Vs + kr * 136 + part * 16 + 8) = gv1[hh];
        }
        if (kt + 1 < NT) ATT_FETCH(kt + 1);
        __syncthreads();
        bf16x8 pf[2][4];
#pragma unroll
        for (int m = 0; m < 2; ++m) {
            f32x4 s[8];
#pragma unroll
            for (int kb = 0; kb < 8; ++kb) {
                s[kb] = (f32x4){0.f, 0.f, 0.f, 0.f};
#pragma unroll
                for (int ks = 0; ks < 2; ++ks) { const bf16x8 a = *(const LAS bf16x8*)(Kt + (16 * kb + r) * 136 + m * 64 + ks * 32 + q4 * 8); s[kb] = MFMA16(a, qf[m][ks], s[kb]); }
            }
            if (kt == qb) {
                const int qpos = 128 * qb + 16 * w + r;
#pragma unroll
                for (int kb = 0; kb < 8; ++kb)
#pragma unroll
                    for (int e = 0; e < 4; ++e) if (128 * kt + 16 * kb + 4 * q4 + e > qpos) s[kb][e] = -INFINITY;
            }
            float mx = -INFINITY;
#pragma unroll
            for (int kb = 0; kb < 8; ++kb)
#pragma unroll
                for (int e = 0; e < 4; ++e) mx = fmaxf(mx, s[kb][e]);
            mx = fmaxf(mx, __shfl_xor(mx, 16)); mx = fmaxf(mx, __shfl_xor(mx, 32));
            const float mnew = fmaxf(mrow[m], mx);
            const float alpha = __builtin_amdgcn_exp2f(mrow[m] - mnew);
            mrow[m] = mnew;
            float ps = 0.f;
#pragma unroll
            for (int kb = 0; kb < 8; ++kb)
#pragma unroll
                for (int e = 0; e < 4; ++e) { s[kb][e] = __builtin_amdgcn_exp2f(s[kb][e] - mnew); ps += s[kb][e]; }
            lrow[m] = lrow[m] * alpha + ps;
            if (__builtin_amdgcn_ballot_w64(alpha != 1.0f) != 0ull) {
#pragma unroll
                for (int vb = 0; vb < 8; ++vb) O[m][vb] = O[m][vb] * alpha;
            }
#pragma unroll
            for (int s2 = 0; s2 < 4; ++s2) { u32x4v o; o.x = pk2(s[2 * s2][0], s[2 * s2][1]); o.y = pk2(s[2 * s2][2], s[2 * s2][3]); o.z = pk2(s[2 * s2 + 1][0], s[2 * s2 + 1][1]); o.w = pk2(s[2 * s2 + 1][2], s[2 * s2 + 1][3]);
                pf[m][s2] = __builtin_bit_cast(bf16x8, o); }
        }
#pragma unroll
        for (int vb = 0; vb < 8; ++vb)
#pragma unroll
            for (int s2 = 0; s2 < 4; ++s2) {
                const v4i16_t lo = __builtin_amdgcn_ds_read_tr16_b64_v4i16((LAS v4i16_t*)(Vs + (32 * s2 + 4 * q4 + r4) * 136 + 16 * vb + 4 * c4));
                const v4i16_t hi = __builtin_amdgcn_ds_read_tr16_b64_v4i16((LAS v4i16_t*)(Vs + (32 * s2 + 16 + 4 * q4 + r4) * 136 + 16 * vb + 4 * c4));
                const bf16x8 vfr = (bf16x8){lo[0], lo[1], lo[2], lo[3], hi[0], hi[1], hi[2], hi[3]};
                O[0][vb] = MFMA16(vfr, pf[0][s2], O[0][vb]); O[1][vb] = MFMA16(vfr, pf[1][s2], O[1][vb]);
            }
    }
#undef ATT_FETCH
    float l0 = lrow[0], l1 = lrow[1];
    l0 += __shfl_xor(l0, 16); l0 += __shfl_xor(l0, 32); l1 += __shfl_xor(l1, 16); l1 += __shfl_xor(l1, 32);
    const float i0 = 1.0f / l0, i1 = lam / l1;
    float ss = 0.f;
#pragma unroll
    for (int vb = 0; vb < 8; ++vb)
#pragma unroll
        for (int e = 0; e < 4; ++e) { const float o = O[0][vb][e] * i0 - O[1][vb][e] * i1; O[0][vb][e] = o; ss += o * o; }
    ss += __shfl_xor(ss, 16); ss += __shfl_xor(ss, 32);
    const float rstd = rsqrtf(ss * (1.f / 128.f) + 1e-6f) * (1.0f - lam_init);
    const float* sw = c.in[28 + z_] + l * 128;
    bf16* orow = ((bf16*)(wsl + WS_MIXED)) + (seq0 + 128 * qb + 16 * w + r) * 2048 + 1024 + h * 128;
#pragma unroll
    for (int vb = 0; vb < 8; ++vb) { const int v0 = 16 * vb + 4 * q4; u32x2v o;
        o.x = pk2(O[0][vb][0] * rstd * sw[v0], O[0][vb][1] * rstd * sw[v0 + 1]); o.y = pk2(O[0][vb][2] * rstd * sw[v0 + 2], O[0][vb][3] * rstd * sw[v0 + 3]);
        *(u32x2v*)(orow + v0) = o; }
}

__device__ __forceinline__ void m1_phase(const Args& c, int l, LAS unsigned char* lds, int G, int mode) {
    int tid_ = threadIdx.x; asm volatile("" : "+v"(tid_)); unsigned char* wsl = c.ws; asm volatile("" : "+s"(wsl)); int z_ = 0; asm volatile("" : "+s"(z_));
    if (mode & 1) for (int u = blockIdx.x; u < 1024; u += G) rwkv_prep_unit(c, u, l, lds);
    if (mode & 2) for (int u = blockIdx.x; u < 1024; u += G) gdn_prep_unit(c, u, l, lds);
}
__device__ __forceinline__ void m2_phase(const Args& c, int l, LAS unsigned char* lds, int G, int mode, bool dry, int cidx) {
    int tid_ = threadIdx.x; asm volatile("" : "+v"(tid_)); unsigned char* wsl = c.ws; asm volatile("" : "+s"(wsl)); int z_ = 0; asm volatile("" : "+s"(z_));
    const int bx = blockIdx.x;
    unsigned* rdone = ((unsigned*)(wsl + WS_CTL)) + 64 * (8 + cidx);
    if (bx < 32) { if (mode & 1) { rwkv_scan(c, bx, l, lds, dry);
            __threadfence(); __syncthreads(); if (tid_ == 0) __hip_atomic_fetch_add(rdone, 1u, __ATOMIC_RELAXED, __HIP_MEMORY_SCOPE_AGENT); } }
    else if (bx < 64) { if (mode & 2) gdn_scan(c, bx - 32, l, lds); }
    if (!(mode & 4)) return;
    float d1 = c.in[24 + z_][l * 64 + (tid_ & 63)] * c.in[25 + z_][l * 64 + (tid_ & 63)], d2 = c.in[26 + z_][l * 64 + (tid_ & 63)] * c.in[27 + z_][l * 64 + (tid_ & 63)];
    d1 = wave_sum(d1); d2 = wave_sum(d2);
    const float lam_init = 0.8f - 0.6f * expf(-0.3f * (float)l);
    const float lam = expf(d1) - expf(d2) + lam_init;
    LAS int* slot = (LAS int*)(lds + LDS_BYTES - 64);
    for (;;) {
        __syncthreads();
        if (tid_ == 0) *slot = (int)atomicAdd((((unsigned*)(wsl + WS_CTL))) + 64 * (1 + l), 1u);
        __syncthreads();
        const int q = *slot;
        if (q >= 1024) break;
        const int qb = 15 - (q >> 6), bhh = q & 63;
        attn_unit(c, l, bhh >> 3, bhh & 7, qb, lam, lam_init, lds);
    }
    if (mode == 7 && !dry) {
        if (tid_ == 0) { unsigned sp = 0; while (__hip_atomic_load(rdone, __ATOMIC_RELAXED, __HIP_MEMORY_SCOPE_AGENT) < 32u) { __builtin_amdgcn_s_sleep(8); if (++sp > (1u << 24)) break; }
            __threadfence(); }
        __syncthreads();
        const int G8 = G * NWAVES, vcu8 = ((G % 8 == 0) ? (bx % 8) * (G / 8) + bx / 8 : bx) * NWAVES + __builtin_amdgcn_readfirstlane(tid_ >> 6);
        rwkv_post(c, l, vcu8, G8);
    }
}
#define XB_TMO      128
#define XB_XCNT(j)  (256  + 64 * (j))
#define XB_XSUB(j)  (1280 + 64 * (j))
#define XB_XGEN(j)  (2304 + 64 * (j))
#define XB_TOP      3328
#define XB_TOPGEN   3392
#define XCD_BAR_WORDS 3456
#define XB_SPIN_CAP (1u << 18)

__device__ __forceinline__ unsigned xb_ld(unsigned* p)              { return __hip_atomic_load(p, __ATOMIC_RELAXED, __HIP_MEMORY_SCOPE_AGENT); }
__device__ __forceinline__ unsigned xb_add(unsigned* p, unsigned v) { return __hip_atomic_fetch_add(p, v, __ATOMIC_RELAXED, __HIP_MEMORY_SCOPE_AGENT); }
__device__ __forceinline__ unsigned xb_xcc_id() { return (unsigned)__builtin_amdgcn_s_getreg((3 << 11) | 20) & 0xFu; }
#define XB_SPIN(cond, bar) do { unsigned _sp = 0; while (cond) { __builtin_amdgcn_s_sleep(1); \
    if ((++_sp & 255u) == 0u) { if (xb_ld(&(bar)[XB_TMO])) break; if (_sp > XB_SPIN_CAP) { atomicAdd(&(bar)[XB_TMO], 1u); break; } } } } while (0)

struct XcdBarrier {
    unsigned* bar; unsigned x;
    volatile LAS unsigned* st;
};

__device__ __forceinline__ XcdBarrier xcd_barrier_post(unsigned* bar, volatile LAS unsigned* st) {
    XcdBarrier b; b.bar = bar; b.x = xb_xcc_id(); b.st = st;
    if (threadIdx.x == 0) (void)xb_add(&bar[XB_XCNT(b.x)], 1u);
    return b;
}
__device__ __forceinline__ void xcd_barrier_complete(unsigned* bar, unsigned x, unsigned& nloc, unsigned& nx) {
    const unsigned G = gridDim.x * gridDim.y * gridDim.z;
    unsigned sum, cnt, mine, sp = 0u;
    for (;;) {
        sum = 0u; cnt = 0u; mine = 0u;
#pragma unroll
        for (unsigned j = 0; j < 16; ++j) { const unsigned c = xb_ld(&bar[XB_XCNT(j)]); sum += c; cnt += (c > 0u) ? 1u : 0u; mine = (j == x) ? c : mine; }
        if (sum == G) break;
        __builtin_amdgcn_s_sleep(1);
        if ((++sp & 255u) == 0u) { if (xb_ld(&bar[XB_TMO])) break; if (sp > XB_SPIN_CAP) { atomicAdd(&bar[XB_TMO], 1u); break; } }
    }
    nloc = mine > 0u ? mine : 1u; nx = cnt > 0u ? cnt : 1u;
}

__device__ __forceinline__ void xcd_barrier(const XcdBarrier& b) {
    asm volatile("s_waitcnt vmcnt(0)" ::: "memory");
    __syncthreads();
    if (threadIdx.x == 0) {
        unsigned* bar = b.bar;
        __builtin_amdgcn_s_waitcnt(0);
        unsigned nloc = b.st[0], nx = b.st[1];
        if (nloc == 0u) { xcd_barrier_complete(bar, b.x, nloc, nx); b.st[0] = nloc; b.st[1] = nx; }
        const unsigned old = xb_add(&bar[XB_XSUB(b.x)], 1u);
        const unsigned gen = old / nloc;
        if (old + 1u == (gen + 1u) * nloc) {
            __builtin_amdgcn_fence(__ATOMIC_RELEASE, "agent");
            asm volatile("s_waitcnt vmcnt(0)" ::: "memory");
            const unsigned og = xb_add(&bar[XB_TOP], 1u);
            const unsigned tg = og / nx;
            if (og + 1u == (tg + 1u) * nx) xb_add(&bar[XB_TOPGEN], 1u);
            else XB_SPIN(xb_ld(&bar[XB_TOPGEN]) == tg, bar);
            __builtin_amdgcn_fence(__ATOMIC_ACQUIRE, "agent");
            xb_add(&bar[XB_XGEN(b.x)], 1u);
            asm volatile("s_waitcnt vmcnt(0)" ::: "memory");
        } else {
            XB_SPIN(xb_ld(&bar[XB_XGEN(b.x)]) == gen, bar);
            __builtin_amdgcn_fence(__ATOMIC_ACQUIRE, "agent");
            asm volatile("s_waitcnt vmcnt(0)" ::: "memory");
        }
    }
    __syncthreads();
}

#ifndef DUP_K
#define DUP_K -1
#endif
#ifndef DUP_SUB
#define DUP_SUB 7
#endif
#ifndef PH_ON
#define PH_ON 63
#endif
__global__ void __launch_bounds__(NTHR, 2) fwd_kernel(Args args) {
    extern __shared__ __attribute__((aligned(16))) unsigned char lds_raw[];
    LAS unsigned char* lds = (LAS unsigned char*)lds_raw;
    const Args& c = args;
    const int G = gridDim.x, bx = blockIdx.x;
    const int vcu = (G % 8 == 0) ? (bx % 8) * (G / 8) + bx / 8 : bx;
    cg::grid_group grid = cg::this_grid();
    for (int u = threadIdx.x; u < 32; u += NTHR) ((LAS unsigned*)(lds + LDS_BYTES - 128))[u] = 0u;
    __syncthreads();
    XcdBarrier xbar = xcd_barrier_post((unsigned*)(c.ws + WS_CTL) + 1024, (volatile LAS unsigned*)(lds + LDS_BYTES - 32));
    int nsync = 0;
#define GRID_SYNC() do { if (nsync == 0) grid.sync(); else xcd_barrier(xbar); ++nsync; } while (0)
    for (int ph = args.ph_lo; ph < args.ph_hi; ++ph) {
        const int l = (ph == 0) ? 0 : (ph - 1) / 9, k = (ph == 0) ? 0 : ((ph - 1) % 9) + 1;
        if (k == 4) continue;
        const int reps = (k == DUP_K) ? 2 : 1;
        for (int rep = 0; rep < reps; ++rep) {
        if (rep) GRID_SYNC();
        if (k == 0 || k == 9) { if (PH_ON & 1) prep_phase(c, (k == 0) ? 0 : l + 1, lds, vcu, G); }
        else if (k == 1) { pg8::Gemm g{((bf16*)(c.ws + WS_H)), ((bf16*)(c.ws + WS_WIN)), M, PW, D}; pg8::StaticOrder S; S.init(M, PW, G, bx); pg8::EpiBf16 E{((bf16*)(c.ws + WS_P)), PW};
            if (PH_ON & 2) pg8::gemm_phase<pg8::EpiBf16, pg8::StaticOrder, true, true>(lds, g, S, E); }
        else if (k == 2) { if (PH_ON & 4) m1_phase(c, l, lds, G, (reps == 2 && rep == 0) ? DUP_SUB : 3); }
        else if (k == 3) { if (PH_ON & 8) { if (reps == 1) m2_phase(c, l, lds, G, 7, false, l); else if (rep == 0) m2_phase(c, l, lds, G, DUP_SUB, true, l + 2); else m2_phase(c, l, lds, G, 7, false, l); } }
        else if (k == 4) { int t4 = threadIdx.x; asm volatile("" : "+v"(t4)); rwkv_post(c, l, vcu * NWAVES + __builtin_amdgcn_readfirstlane(t4 >> 6), G * NWAVES); }
        else if (k == 5 || k == 8) { pg8::Gemm g{(k == 5) ? ((bf16*)(c.ws + WS_MIXED)) : ((bf16*)(c.ws + WS_P)), (k == 5) ? ((bf16*)(c.ws + WS_WOUT)) : ((bf16*)(c.ws + WS_WFO)), M, D, (k == 5) ? D : FF}; pg8::StaticOrder S; S.init(M, D, G, bx);
            pg8::EpiResAdd E{(k == 5 && l == 0) ? c.in[0] : c.out, c.out, D};
            if (PH_ON & 16) pg8::gemm_phase<pg8::EpiResAdd, pg8::StaticOrder, true, true>(lds, g, S, E); }
        else if (k == 6) { int t5 = threadIdx.x; asm volatile("" : "+v"(t5)); const int wave = __builtin_amdgcn_readfirstlane(t5 >> 6); norm_rows(c.out, c.in[30] + (size_t)l * D, (bf16*)(c.ws + WS_H), vcu * NWAVES + wave, G * NWAVES, t5 & 63); }
        else if (k == 7) { pg8::Gemm g{((bf16*)(c.ws + WS_H)), ((bf16*)(c.ws + WS_WFI)), M, 2 * FF, D}; pg8::StaticOrder S; S.init(M, 2 * FF, G, bx); pg8::EpiSwiglu E{((bf16*)(c.ws + WS_P)), FF};
            if (PH_ON & 32) pg8::gemm_phase<pg8::EpiSwiglu, pg8::StaticOrder, true, true>(lds, g, S, E); }
        }
        if (ph + 1 < args.ph_hi) GRID_SYNC();
#if defined(DUP_SYNC)
        GRID_SYNC();
#endif
    }
}

#ifndef ONE_LAUNCH
#define ONE_LAUNCH 1
#endif
constexpr int N_PHASES = 18;
extern "C" void kernel_launch(void* const* d_in, const int* in_sizes, int n_in, void* d_out, int out_size, void* d_ws, size_t ws_size, hipStream_t stream) {
    static int grid = 0;
    if (grid == 0) {
        if (n_in != 33 || out_size != M * D || ws_size < WS_END) { fprintf(stderr, "kernel_launch: unexpected shapes (n_in %d out %d ws %zu, need %zu)\n", n_in, out_size, ws_size, (size_t)WS_END); grid = -1; return; }
        int dev = 0, cus = 0, per_cu = 0;
        hipGetDevice(&dev); hipDeviceGetAttribute(&cus, hipDeviceAttributeMultiprocessorCount, dev);
        if (hipFuncSetAttribute((const void*)fwd_kernel, hipFuncAttributeMaxDynamicSharedMemorySize, LDS_BYTES) != hipSuccess) { fprintf(stderr, "kernel_launch: hipFuncSetAttribute failed\n"); grid = -1; return; }
        if (hipOccupancyMaxActiveBlocksPerMultiprocessor(&per_cu, (const void*)fwd_kernel, NTHR, LDS_BYTES) != hipSuccess || per_cu < 1) { fprintf(stderr, "kernel_launch: occupancy query says %d\n", per_cu); per_cu = 1; }
        (void)hipGetLastError();
        grid = cus * 1;
        fprintf(stderr, "kernel_launch: grid %d (cus %d, per_cu %d)\n", grid, cus, per_cu);
    }
    if (grid < 0) return;
    (void)hipMemsetAsync((char*)d_ws + WS_CTL, 0, 65536, stream);
    Args a{};
    for (int i = 0; i < 33; ++i) a.in[i] = (const float*)d_in[i];
    a.out = (float*)d_out; a.ws = (unsigned char*)d_ws;
#if ONE_LAUNCH
    a.ph_lo = 0; a.ph_hi = N_PHASES;
    void* kargs[] = {&a};
    hipError_t e = hipLaunchCooperativeKernel((const void*)fwd_kernel, dim3(grid), dim3(NTHR), kargs, LDS_BYTES, stream);
    if (e != hipSuccess) fprintf(stderr, "kernel_launch: cooperative launch failed: %s\n", hipGetErrorString(e));
#else
    for (int ph = 0; ph < N_PHASES; ++ph) { a.ph_lo = ph; a.ph_hi = ph + 1; hipLaunchKernelGGL(fwd_kernel, dim3(grid), dim3(NTHR), LDS_BYTES, stream, a); }
#endif
}
```

```cpp
#include <hip/hip_runtime.h>
#include <hip/hip_cooperative_groups.h>
#include <cstdio>
#include <cstdint>
namespace cg = cooperative_groups;
namespace pg8 {
#define PG8_LAS __attribute__((address_space(3)))
typedef unsigned short bf16_t;
typedef short bf16x8 __attribute__((ext_vector_type(8)));
typedef float f32x4 __attribute__((ext_vector_type(4)));
typedef unsigned u32x4 __attribute__((ext_vector_type(4)));
constexpr int BM = 256, BK = 64, HALF = 128, HTB = HALF * BK * 2  , STAGE_BYTES = 8 * HTB, NXCD = 8, WGM = 8;

__host__ __device__ __forceinline__ int lds_byte(int r, int c) { const int st = (r >> 4) * 2 + (c >> 5), rr = r & 15, cc = c & 31, ob = rr * 64 + cc * 2; return st * 1024 + (ob ^ (((ob >> 9) & 1) << 5)); }
__host__ __device__ __forceinline__ void stage_rc(int b, int& R, int& C) { const int st = b / 1024, sb = b % 1024, swz = sb ^ (((sb >> 9) & 1) << 5); R = (st >> 1) * 16 + swz / 64; C = (st & 1) * 32 + (swz % 64) / 2; }
__host__ __device__ __forceinline__ int perm32(int rho) { const int n = rho >> 4, i = rho & 15; return 8 * (i >> 2) + 4 * n + (i & 3); }

struct Unit { int pm, pn; };
struct Gemm { const bf16_t* A; const bf16_t* Bt; int M, N, K; };

struct StaticOrder {
    int nM, nN, nwg, G, c;
    __host__ __device__ void init(int M, int N, int G_, int c_) { nM = M / BM; nN = N / BM; nwg = nM * nN; G = G_; c = c_; }
    __host__ __device__ bool next(int i, Unit& u) const {
        const long L = (long)i * G + c; if (L >= nwg) return false;
        int wgid = (int)L; { const int q = nwg / NXCD, r = nwg % NXCD, xcd = wgid % NXCD, off = wgid / NXCD; wgid = (xcd < r ? xcd * (q + 1) : r * (q + 1) + (xcd - r) * q) + off; }
        const int nig = WGM * nN, gid = wgid / nig, fm = gid * WGM, gsz = (nM - fm) < WGM ? (nM - fm) : WGM;
        u.pm = fm + ((wgid % nig) % gsz); u.pn = (wgid % nig) / gsz; return true;
    }
    __device__ __forceinline__ void a_ready(const Unit&) const {}
    __device__ __forceinline__ void done(const Unit&) const {}
};

__device__ __forceinline__ unsigned cvt_pk_bf16(float lo, float hi) { unsigned r; asm volatile("v_cvt_pk_bf16_f32 %0, %1, %2" : "=v"(r) : "v"(lo), "v"(hi)); return r; }
struct EpiBf16 {
    static constexpr bool PERM = true, AFTER_DRAIN = false;
    bf16_t* O; int ldc;
    __device__ __forceinline__ void operator()(const f32x4 (&acc)[2][2][4][2], const Unit& u, int wr, int wc, int fr, int fq) const {
        const int row0 = u.pm * BM + wr * 64 + fr; const int col0 = u.pn * BM + wc * 32 + 8 * fq;
#pragma unroll
        for (int ai = 0; ai < 2; ++ai)
#pragma unroll
            for (int m = 0; m < 4; ++m) { bf16_t* rowp = O + (size_t)(row0 + ai * HALF + m * 16) * ldc + col0;
#pragma unroll
                for (int bj = 0; bj < 2; ++bj) { const f32x4 v0 = acc[ai][bj][m][0], v1 = acc[ai][bj][m][1];
                    u32x4 w; w.x = cvt_pk_bf16(v0[0], v0[1]); w.y = cvt_pk_bf16(v0[2], v0[3]); w.z = cvt_pk_bf16(v1[0], v1[1]); w.w = cvt_pk_bf16(v1[2], v1[3]);
                    *(u32x4*)(rowp + bj * HALF) = w; } }
    }
};
struct EpiSwiglu {
    static constexpr bool PERM = true, AFTER_DRAIN = false;
    bf16_t* O; int ldc;
    __device__ __forceinline__ void operator()(const f32x4 (&acc)[2][2][4][2], const Unit& u, int wr, int wc, int fr, int fq) const {
        typedef unsigned u32x2 __attribute__((ext_vector_type(2)));
        const int row0 = u.pm * BM + wr * 64 + fr; const int col0 = u.pn * 128 + wc * 16 + 4 * fq;
#pragma unroll
        for (int ai = 0; ai < 2; ++ai)
#pragma unroll
            for (int m = 0; m < 4; ++m) { bf16_t* rowp = O + (size_t)(row0 + ai * HALF + m * 16) * ldc + col0;
#pragma unroll
                for (int bj = 0; bj < 2; ++bj) { const f32x4 g = acc[ai][bj][m][0], up = acc[ai][bj][m][1]; float a[4];
#pragma unroll
                    for (int e = 0; e < 4; ++e) a[e] = g[e] * __builtin_amdgcn_rcpf(1.0f + __expf(-g[e])) * up[e];
                    u32x2 w; w.x = cvt_pk_bf16(a[0], a[1]); w.y = cvt_pk_bf16(a[2], a[3]);
                    *(u32x2*)(rowp + bj * 64) = w; } }
    }
};
struct EpiResAdd {
    static constexpr bool PERM = false, AFTER_DRAIN = false;
    const float* base; float* out; int ldc;
    __device__ __forceinline__ void operator()(const f32x4 (&acc)[2][2][4][2], const Unit& u, int wr, int wc, int fr, int fq) const {
        const int row0 = u.pm * BM + wr * 64 + fr; const int col0 = u.pn * BM + wc * 32 + 4 * fq;
#pragma unroll
        for (int ai = 0; ai < 2; ++ai) {
            f32x4 b[4][2][2];
#pragma unroll
            for (int m = 0; m < 4; ++m) { const size_t off = (size_t)(row0 + ai * HALF + m * 16) * ldc + col0;
#pragma unroll
                for (int bj = 0; bj < 2; ++bj)
#pragma unroll
                    for (int n = 0; n < 2; ++n) b[m][bj][n] = *(const f32x4*)(base + off + bj * HALF + n * 16); }
            asm volatile("" ::: "memory");
#pragma unroll
            for (int m = 0; m < 4; ++m) { const size_t off = (size_t)(row0 + ai * HALF + m * 16) * ldc + col0;
#pragma unroll
                for (int bj = 0; bj < 2; ++bj)
#pragma unroll
                    for (int n = 0; n < 2; ++n) *(f32x4*)(out + off + bj * HALF + n * 16) = b[m][bj][n] + acc[ai][bj][m][n]; }
        }
    }
};
template <class Epi, class Sched, bool ALIGN_EPI = false, bool SP2 = false>
__device__ __forceinline__ void gemm_phase(PG8_LAS unsigned char* lds, const Gemm g, const Sched& S, const Epi& E) {
    int tid = threadIdx.x; asm volatile("" : "+v"(tid)); const int wid = __builtin_amdgcn_readfirstlane(tid >> 6), lane = tid & 63, wr = wid >> 2, wc = wid & 3, fr = lane & 15, fq = lane >> 4;
    const int K = g.K, nt = K / BK;
    unsigned voffA[2], voffB[2];
#pragma unroll
    for (int i = 0; i < 2; ++i) { int R, C; stage_rc(tid * 16 + i * 8192, R, C); const int Rb = Epi::PERM ? ((R & ~31) + perm32(R & 31)) : R;
        voffA[i] = (unsigned)(R * K + C) * 2u; voffB[i] = (unsigned)(Rb * K + C) * 2u; }
    const size_t kstep = (size_t)(BK * 2);
    const size_t hstep = (size_t)HALF * K * 2;
    const size_t tstep = 2 * hstep;
    const unsigned ldsw = (unsigned)wid * 1024u;
    const int aoff = lds_byte(wr * 64 + fr, fq * 8), boff = lds_byte(wc * 32 + fr, fq * 8);
#define PG8_SA(b, h) (((b) * 2 + (h)) * HTB)
#define PG8_SB(b, h) ((4 + (b) * 2 + (h)) * HTB)
#define PG8_STAGE(bufoff, gbase, voff) do { _Pragma("unroll") for (int _i = 0; _i < 2; ++_i) \
        __builtin_amdgcn_global_load_lds((const unsigned*)((const char*)(gbase) + (voff)[_i]), (PG8_LAS unsigned*)(lds + (bufoff) + ldsw + _i * 8192), 16, 0, 0); } while (0)
#define PG8_LDA(dst, b, h) do { _Pragma("unroll") for (int m = 0; m < 4; ++m) _Pragma("unroll") for (int k = 0; k < 2; ++k) dst[m][k] = *(const PG8_LAS bf16x8*)(lds + PG8_SA(b, h) + aoff + m * 2048 + k * 1024); } while (0)
#define PG8_LDB(dst, b, h) do { _Pragma("unroll") for (int n = 0; n < 2; ++n) _Pragma("unroll") for (int k = 0; k < 2; ++k) dst[n][k] = *(const PG8_LAS bf16x8*)(lds + PG8_SB(b, h) + boff + n * 2048 + k * 1024); } while (0)
#define PG8_MMA(ai, bj, At, Bt) do { __builtin_amdgcn_s_setprio(1); _Pragma("unroll") for (int m = 0; m < 4; ++m) _Pragma("unroll") for (int n = 0; n < 2; ++n) _Pragma("unroll") for (int k = 0; k < 2; ++k) \
        acc[ai][bj][m][n] = __builtin_amdgcn_mfma_f32_16x16x32_bf16(Bt[n][k], At[m][k], acc[ai][bj][m][n], 0, 0, 0); __builtin_amdgcn_s_setprio(0); } while (0)
#define PG8_WAIT_V(n) asm volatile("s_waitcnt vmcnt(" #n ")" ::: "memory")
#define PG8_WAIT_L(n) asm volatile("s_waitcnt lgkmcnt(" #n ")" ::: "memory")
#define PG8_BAR __builtin_amdgcn_s_barrier()
#define PG8_SCHED __builtin_amdgcn_sched_barrier(0)
    Unit cur, nxt; int ui = 0;
    if (!S.next(0, cur)) return;
    f32x4 acc[2][2][4][2];
#pragma unroll
    for (int a = 0; a < 2; ++a)
#pragma unroll
        for (int b = 0; b < 2; ++b)
#pragma unroll
            for (int m = 0; m < 4; ++m)
#pragma unroll
                for (int n = 0; n < 2; ++n) acc[a][b][m][n] = (f32x4){0.f, 0.f, 0.f, 0.f};
    bf16x8 At[4][2], B0[2][2], B1[2][2];
    const char* cA = (const char*)g.A + (size_t)cur.pm * tstep; const char* cB = (const char*)g.Bt + (size_t)cur.pn * tstep;
    S.a_ready(cur);
    if constexpr (SP2) {
        PG8_STAGE(PG8_SB(0, 0), cB, voffB); PG8_STAGE(PG8_SB(0, 1), cB + hstep, voffB); PG8_STAGE(PG8_SA(0, 0), cA, voffA); PG8_STAGE(PG8_SA(0, 1), cA + hstep, voffA);
        if (wr == 1) PG8_BAR;
        PG8_WAIT_V(2); PG8_BAR;
        PG8_STAGE(PG8_SB(1, 0), cB + kstep, voffB); PG8_STAGE(PG8_SA(1, 0), cA + kstep, voffA); PG8_STAGE(PG8_SB(1, 1), cB + hstep + kstep, voffB);
        PG8_WAIT_V(6); PG8_BAR;
    } else {
        PG8_STAGE(PG8_SB(0, 0), cB, voffB); PG8_STAGE(PG8_SA(0, 0), cA, voffA); PG8_STAGE(PG8_SB(0, 1), cB + hstep, voffB); PG8_STAGE(PG8_SA(0, 1), cA + hstep, voffA);
        if (wr == 1) PG8_BAR;
        PG8_WAIT_V(4); PG8_BAR;
        PG8_STAGE(PG8_SB(1, 0), cB + kstep, voffB); PG8_STAGE(PG8_SA(1, 0), cA + kstep, voffA); PG8_STAGE(PG8_SB(1, 1), cB + hstep + kstep, voffB);
        PG8_WAIT_V(6); PG8_BAR;
    }
    for (;;) {
        const bool has_next = S.next(ui + 1, nxt);
        const char* nA = has_next ? (const char*)g.A + (size_t)nxt.pm * tstep : cA; const char* nB = has_next ? (const char*)g.Bt + (size_t)nxt.pn * tstep : cB;
        for (int t = 0; t < nt; t += 2) {
            const bool last = (t == nt - 2);
            const char* a1 = cA + (size_t)(t + 1) * kstep;
            const char* a2 = last ? nA : cA + (size_t)(t + 2) * kstep; const char* b2 = last ? nB : cB + (size_t)(t + 2) * kstep;
            const char* a3 = a2 + kstep; const char* b3 = b2 + kstep;
            if (last && has_next) S.a_ready(nxt);
            if constexpr (SP2) {
            PG8_LDB(B0, 0, 0); PG8_LDB(B1, 0, 1); PG8_SCHED; PG8_LDA(At, 0, 0); PG8_STAGE(PG8_SA(1, 1), a1 + hstep, voffA);
            PG8_WAIT_V(8); PG8_WAIT_L(0); PG8_BAR; PG8_MMA(0, 0, At, B0); PG8_MMA(0, 1, At, B1); PG8_BAR; PG8_SCHED;
            PG8_LDA(At, 0, 1); PG8_STAGE(PG8_SB(0, 0), b2, voffB); PG8_STAGE(PG8_SB(0, 1), b2 + hstep, voffB); PG8_STAGE(PG8_SA(0, 0), a2, voffA);
            PG8_WAIT_V(8); PG8_WAIT_L(0); PG8_BAR; PG8_MMA(1, 0, At, B0); PG8_MMA(1, 1, At, B1); PG8_BAR; PG8_SCHED;
            PG8_LDB(B0, 1, 0); PG8_LDB(B1, 1, 1); PG8_SCHED; PG8_LDA(At, 1, 0); PG8_STAGE(PG8_SA(0, 1), a2 + hstep, voffA);
            PG8_WAIT_V(8); PG8_WAIT_L(0); PG8_BAR; PG8_MMA(0, 0, At, B0); PG8_MMA(0, 1, At, B1); PG8_BAR; PG8_SCHED;
            PG8_LDA(At, 1, 1); PG8_STAGE(PG8_SB(1, 0), b3, voffB); PG8_STAGE(PG8_SB(1, 1), b3 + hstep, voffB); PG8_STAGE(PG8_SA(1, 0), a3, voffA);
            PG8_WAIT_V(8); PG8_WAIT_L(0); PG8_BAR; PG8_MMA(1, 0, At, B0); PG8_MMA(1, 1, At, B1); PG8_BAR; PG8_SCHED;
            } else {
            PG8_LDB(B0, 0, 0); PG8_SCHED; PG8_LDA(At, 0, 0); PG8_STAGE(PG8_SA(1, 1), a1 + hstep, voffA);
            PG8_WAIT_L(8); PG8_BAR; PG8_WAIT_L(0); PG8_MMA(0, 0, At, B0); PG8_BAR; PG8_SCHED;
            PG8_LDB(B1, 0, 1); PG8_STAGE(PG8_SB(0, 0), b2, voffB);
            PG8_BAR; PG8_WAIT_L(0); PG8_MMA(0, 1, At, B1); PG8_BAR;
            PG8_LDA(At, 0, 1); PG8_STAGE(PG8_SA(0, 0), a2, voffA);
            PG8_BAR; PG8_WAIT_L(0); PG8_MMA(1, 0, At, B0); PG8_BAR; PG8_SCHED;
            PG8_STAGE(PG8_SB(0, 1), b2 + hstep, voffB);
            PG8_WAIT_V(6); PG8_BAR; PG8_MMA(1, 1, At, B1); PG8_BAR;
            PG8_LDB(B0, 1, 0); PG8_SCHED; PG8_LDA(At, 1, 0); PG8_STAGE(PG8_SA(0, 1), a2 + hstep, voffA);
            PG8_WAIT_L(8); PG8_BAR; PG8_WAIT_L(0); PG8_MMA(0, 0, At, B0); PG8_BAR; PG8_SCHED;
            PG8_LDB(B1, 1, 1); PG8_STAGE(PG8_SB(1, 0), b3, voffB);
            PG8_BAR; PG8_WAIT_L(0); PG8_MMA(0, 1, At, B1); PG8_BAR;
            PG8_LDA(At, 1, 1); PG8_STAGE(PG8_SA(1, 0), a3, voffA);
            PG8_BAR; PG8_WAIT_L(0); PG8_MMA(1, 0, At, B0); PG8_BAR; PG8_SCHED;
            PG8_STAGE(PG8_SB(1, 1), b3 + hstep, voffB);
            PG8_WAIT_V(6); PG8_BAR; PG8_MMA(1, 1, At, B1); PG8_BAR;
            }
        }
        if constexpr (ALIGN_EPI) { if (wr == 0) PG8_BAR; }
        if constexpr (!Epi::AFTER_DRAIN) { E(acc, cur, wr, wc, fr, fq); S.done(cur); }
        if (!has_next) break;
#pragma unroll
        for (int a = 0; a < 2; ++a)
#pragma unroll
            for (int b = 0; b < 2; ++b)
#pragma unroll
                for (int m = 0; m < 4; ++m)
#pragma unroll
                    for (int n = 0; n < 2; ++n) acc[a][b][m][n] = (f32x4){0.f, 0.f, 0.f, 0.f};
        cur = nxt; cA = nA; cB = nB; ++ui;
        if constexpr (ALIGN_EPI) { if (wr == 1) PG8_BAR; }
    }
    PG8_WAIT_V(0);
    if constexpr (!ALIGN_EPI) { if (wr == 0) PG8_BAR; }
    PG8_BAR;
    if constexpr (Epi::AFTER_DRAIN) { E.fused(acc, cur, wr, wc, fr, fq, lds, wid, lane); S.done(cur); }
#undef PG8_SA
#undef PG8_SB
#undef PG8_STAGE
#undef PG8_LDA
#undef PG8_LDB
#undef PG8_MMA
#undef PG8_WAIT_V
#undef PG8_WAIT_L
#undef PG8_BAR
#undef PG8_SCHED
}
}
#define LAS __attribute__((address_space(3)))
typedef unsigned short bf16;
typedef float f32x4 __attribute__((ext_vector_type(4)));
typedef float f32x8 __attribute__((ext_vector_type(8)));
typedef short bf16x8 __attribute__((ext_vector_type(8)));
typedef unsigned u32x4v __attribute__((ext_vector_type(4)));
typedef unsigned u32x2v __attribute__((ext_vector_type(2)));
constexpr int NB = 8, T = 2048, D = 2048, M = NB * T, FF = 5632, PW = 7168, NINW = 6920;
constexpr int GDN_BASE = 1856, DIFF_BASE = 3968;
constexpr int NWAVES = 8, NTHR = 512;
constexpr size_t MiB = 1u << 20;
constexpr size_t WS_CTL = 0, WS_WIN = 1 * MiB, WS_AT = 1 * MiB  , WS_GL = 9 * MiB, WS_WOUT = 29 * MiB, WS_WFI = 37 * MiB, WS_WFO = 81 * MiB, WS_LORA = 103 * MiB, WS_H = 104 * MiB,
                 WS_P = 168 * MiB, WS_MIXED = 392 * MiB, WS_VFIRST = 456 * MiB, WS_RW = 472 * MiB, WS_WR0 = 600 * MiB, WS_WR1 = 632 * MiB, WS_V = 664 * MiB, WS_SC0 = 696 * MiB, WS_SC1 = 698 * MiB,
                 WS_END = 700 * MiB;
constexpr size_t RWSZ = (size_t)M * 512;
constexpr int LDS_BYTES = 147456;
#define MFMA16(a, b, c) __builtin_amdgcn_mfma_f32_16x16x32_bf16(a, b, c, 0, 0, 0)

struct Args { const float* in[33]; float* out; unsigned char* ws; int ph_lo, ph_hi; };

__device__ __forceinline__ float bf2f(unsigned h) { return __builtin_bit_cast(float, h << 16); }
typedef float f32x2_t __attribute__((ext_vector_type(2))); typedef __bf16 bf16x2_t __attribute__((ext_vector_type(2)));
__device__ __forceinline__ unsigned pk2(float lo, float hi) { f32x2_t v = {lo, hi}; bf16x2_t b = __builtin_convertvector(v, bf16x2_t); return __builtin_bit_cast(unsigned, b); }
__device__ __forceinline__ unsigned f2bf(float f) { return pk2(f, f) & 0xffffu; }
__device__ __forceinline__ float bflo(unsigned w) { return __builtin_bit_cast(float, w << 16); }
__device__ __forceinline__ float bfhi(unsigned w) { return __builtin_bit_cast(float, w & 0xffff0000u); }
__device__ __forceinline__ float sigmoidf_(float x) { return __builtin_amdgcn_rcpf(1.0f + __expf(-x)); }
__device__ __forceinline__ float softplusf_(float x) { return fmaxf(x, 0.f) + __logf(1.0f + __expf(-fabsf(x))); }
__device__ __forceinline__ float tanhf_(float x) { const float e = __expf(-2.0f * fabsf(x)); const float t = (1.0f - e) * __builtin_amdgcn_rcpf(1.0f + e); return x < 0.f ? -t : t; }
__device__ __forceinline__ float wave_sum(float v) {
#pragma unroll
    for (int o = 1; o < 64; o <<= 1) v += __shfl_xor(v, o);
    return v;
}
__device__ __forceinline__ void unpack8(u32x4v w, float* f) { f[0] = bflo(w.x); f[1] = bfhi(w.x); f[2] = bflo(w.y); f[3] = bfhi(w.y); f[4] = bflo(w.z); f[5] = bfhi(w.z); f[6] = bflo(w.w); f[7] = bfhi(w.w); }
#define ROR_ADD(x, n) x += __builtin_bit_cast(float, __builtin_amdgcn_update_dpp(0, __builtin_bit_cast(int, x), 0x120 + (n), 0xf, 0xf, false))
#define BAR_LDS() do { asm volatile("s_waitcnt lgkmcnt(0)" ::: "memory"); __builtin_amdgcn_s_barrier(); asm volatile("" ::: "memory"); } while (0)

__device__ __forceinline__ int src_col(int mode, int n) {
    if (mode == 0) return n;
    if (mode == 2) { const int g = n >> 3, e = n & 7; return (e < 4) ? 4 * g + e : FF + 4 * g + (e - 4); }
    if (n < 1792) return n;
    if (n < 1824) return -2;
    if (n < GDN_BASE) return -1;
    if (n < GDN_BASE + 2056) return 1792 + (n - GDN_BASE);
    if (n < DIFF_BASE) return -1;
    if (n < DIFF_BASE + 3072) return 3848 + (n - DIFF_BASE);
    return -1;
}
__device__ __forceinline__ void transpose_item(const float* W, int K, int N, bf16* WT, LAS float* scr, int item, int nblk, int lane, int mode, const float* W2) {
    const int kb = item / nblk, nb = item % nblk, k0 = 64 * kb, n0 = 128 * nb;
    const int c32 = lane & 31, nn = n0 + 4 * c32;
    const int sc = src_col(mode, nn);
    f32x4 vals[32];
    {
        const bool useW = sc >= 0, use2 = (sc == -2) && (W2 != nullptr);
        const float* pl = useW ? W + (size_t)(k0 + (lane >> 5)) * N + sc : (use2 ? W2 + (size_t)(k0 + (lane >> 5)) * 32 + (nn - 1792) : W);
        const size_t step = useW ? (size_t)2 * N : (use2 ? 64 : 0);
#pragma unroll
        for (int i = 0; i < 32; ++i) { f32x4 v = *(const f32x4*)pl; pl += step; if (!(useW || use2)) v = (f32x4){0.f, 0.f, 0.f, 0.f}; vals[i] = v; }
    }
#pragma unroll
    for (int pass = 0; pass < 2; ++pass) {
        if ((c32 >> 4) == pass) {
            const int cc = 4 * (c32 & 15);
#pragma unroll
            for (int i = 0; i < 32; ++i) { LAS float* d = scr + (2 * i + (lane >> 5)) * 65 + cc; d[0] = vals[i].x; d[1] = vals[i].y; d[2] = vals[i].z; d[3] = vals[i].w; }
        }
        asm volatile("s_waitcnt lgkmcnt(0)" ::: "memory");
        const int c = lane & 7;
#pragma unroll
        for (int j = 0; j < 8; ++j) { const int n = (lane >> 3) + 8 * j; const LAS float* s = scr + (8 * c) * 65 + n;
            u32x4v o; o.x = pk2(s[0 * 65], s[1 * 65]); o.y = pk2(s[2 * 65], s[3 * 65]); o.z = pk2(s[4 * 65], s[5 * 65]); o.w = pk2(s[6 * 65], s[7 * 65]);
            *(u32x4v*)(WT + (size_t)(n0 + 64 * pass + n) * K + k0 + 8 * c) = o; }
        asm volatile("s_waitcnt lgkmcnt(0)" ::: "memory");
    }
}
__device__ __forceinline__ void norm_rows(const float* x, const float* w, bf16* H, int gw, int ngw, int lane) {
    for (int m0 = gw; m0 < M; m0 += 4 * ngw) {
        f32x4 v[4][8]; float s[4];
#pragma unroll
        for (int q = 0; q < 4; ++q) { const int m = (m0 + q * ngw < M) ? m0 + q * ngw : m0; const f32x4* xr = (const f32x4*)(x + (size_t)m * D) + lane;
#pragma unroll
            for (int j = 0; j < 8; ++j) v[q][j] = xr[64 * j]; }
#pragma unroll
        for (int q = 0; q < 4; ++q) { float a = 0.f;
#pragma unroll
            for (int j = 0; j < 8; ++j) a += (v[q][j].x * v[q][j].x + v[q][j].y * v[q][j].y) + (v[q][j].z * v[q][j].z + v[q][j].w * v[q][j].w);
            s[q] = rsqrtf(wave_sum(a) * (1.f / D) + 1e-6f); }
#pragma unroll
        for (int j = 0; j < 8; ++j) { const f32x4 ww = ((const f32x4*)w)[lane + 64 * j];
#pragma unroll
            for (int q = 0; q < 4; ++q) { const int m = m0 + q * ngw;
                if (m < M) { u32x2v o; o.x = pk2(v[q][j].x * s[q] * ww.x, v[q][j].y * s[q] * ww.y); o.y = pk2(v[q][j].z * s[q] * ww.z, v[q][j].w * s[q] * ww.w); ((u32x2v*)(H + (size_t)m * D) + lane)[64 * j] = o; } } }
    }
}
__device__ __forceinline__ void prep_phase(const Args& c, int l, LAS unsigned char* lds, int vcu, int G) {
    int tid_ = threadIdx.x; asm volatile("" : "+v"(tid_)); unsigned char* wsl = c.ws; asm volatile("" : "+s"(wsl)); int z_ = 0; asm volatile("" : "+s"(z_));
    const int tid = tid_, lane = tid & 63, wave = __builtin_amdgcn_readfirstlane(tid >> 6);
    LAS float* scr = (LAS float*)(lds + wave * 16640);
    const int gw = vcu * NWAVES + wave, NGW = G * NWAVES;
    constexpr int I_IN = (D / 64) * (PW / 128), I_OUT = (D / 64) * (D / 128), I_FI = (D / 64) * (2 * FF / 128), I_FO = (FF / 64) * (D / 128);
    const float* w_in = c.in[2 + z_] + (size_t)l * D * NINW; const float* w_vres = (l > 0) ? c.in[3 + z_] + (size_t)(l - 1) * D * 32 : nullptr;
    const float* w_out = c.in[29 + z_] + (size_t)l * D * D; const float* w_fi = c.in[31 + z_] + (size_t)l * D * 2 * FF; const float* w_fo = c.in[32 + z_] + (size_t)l * FF * D;
    for (int it = gw; it < I_IN + I_OUT + I_FI + I_FO; it += NGW) {
        int r = it;
        if (r < I_IN) { transpose_item(w_in, D, NINW, ((bf16*)(wsl + WS_WIN)), scr, r, PW / 128, lane, 1, w_vres); continue; } r -= I_IN;
        if (r < I_OUT) { transpose_item(w_out, D, D, ((bf16*)(wsl + WS_WOUT)), scr, r, D / 128, lane, 0, nullptr); continue; } r -= I_OUT;
        if (r < I_FI) { transpose_item(w_fi, D, 2 * FF, ((bf16*)(wsl + WS_WFI)), scr, r, 2 * FF / 128, lane, 2, nullptr); continue; } r -= I_FI;
        transpose_item(w_fo, FF, D, ((bf16*)(wsl + WS_WFO)), scr, r, D / 128, lane, 0, nullptr);
    }
    for (int i = (vcu * NTHR + tid); i < 512 * 288; i += G * NTHR) { const int ch = i / 288, k = i % 288; float v;
        if (k < 64) v = c.in[7 + z_][(size_t)l * 64 * 512 + k * 512 + ch]; else if (k < 128) v = c.in[9 + z_][(size_t)l * 64 * 512 + (k - 64) * 512 + ch];
        else if (k < 256) v = c.in[10 + z_][(size_t)l * 128 * 512 + (k - 128) * 512 + ch]; else v = (l > 0) ? c.in[12 + z_][(size_t)(l - 1) * 32 * 512 + (k - 256) * 512 + ch] : 0.f;
        ((bf16*)(wsl + WS_LORA))[i] = (bf16)f2bf(v); }
    norm_rows(l == 0 ? c.in[0 + z_] : c.out, c.in[1 + z_] + (size_t)l * D, ((bf16*)(wsl + WS_H)), gw, NGW, lane);
}
__device__ __forceinline__ void rwkv_prep_unit(const Args& c, int u, int l, LAS unsigned char* lds) {
    int tid_ = threadIdx.x; asm volatile("" : "+v"(tid_)); unsigned char* wsl = c.ws; asm volatile("" : "+s"(wsl)); int z_ = 0; asm volatile("" : "+s"(z_));
    float* rwb_ = (l == 0) ? c.out : (float*)(wsl + WS_RW); float* rwr_ = (float*)(wsl + (l == 0 ? WS_WR0 : WS_WR1)); float* rsc_ = (float*)(wsl + (l == 0 ? WS_SC0 : WS_SC1));
    const int tid = tid_, lane = tid & 63, w = __builtin_amdgcn_readfirstlane(tid >> 6), r = lane & 15, q4 = lane >> 4;
    const int tok0 = u * 16;
    LAS bf16* xs = (LAS bf16*)lds;
    const bf16* P = ((bf16*)(wsl + WS_P));
    const float* mu = c.in[4 + z_] + (size_t)l * 1792;
    __syncthreads();
#pragma unroll
    for (int it = 0; it < 9; ++it) {
        const int idx = tid + it * NTHR;
        const int t = idx / 288, j = idx % 288, tok = tok0 + t;
        const bool use = (j < 256) || (l > 0);
        const int col = (j < 256) ? 1536 + j : 1792 + (j - 256);
        const float m_ = (j < 256) ? mu[1536 + j] : ((l > 0) ? c.in[5 + z_][(size_t)(l - 1) * 32 + (j - 256)] : 0.f);
        const bool hp = (tok & (T - 1)) != 0;
        const float cur = bf2f(P[(size_t)tok * PW + col]);
        const float pv = bf2f(P[(size_t)(hp ? tok - 1 : tok) * PW + col]);
        const float prev = hp ? pv : 0.f;
        float x = cur + (prev - cur) * m_;
        const float xt = tanhf_(x), xs_ = sigmoidf_(x);
        x = (j < 64) ? xt : ((j >= 128 && j < 256) ? xs_ : x);
        xs[t * 296 + j] = (bf16)f2bf(use ? x : 0.f);
    }
    __syncthreads();
    f32x4 aw[4], aa[4], ag[4], av[4];
#pragma unroll
    for (int jb = 0; jb < 4; ++jb) { aw[jb] = (f32x4){0.f, 0.f, 0.f, 0.f}; aa[jb] = aw[jb]; ag[jb] = aw[jb]; av[jb] = aw[jb]; }
    const bf16* Lt = ((bf16*)(wsl + WS_LORA)) + (size_t)(64 * w + r) * 288 + q4 * 8;
#pragma unroll
    for (int ks = 0; ks < 9; ++ks) {
        const bf16x8 af = *(const LAS bf16x8*)(xs + r * 296 + ks * 32 + q4 * 8);
#pragma unroll
        for (int jb = 0; jb < 4; ++jb) {
            const bf16x8 bf = *(const bf16x8*)(Lt + (size_t)jb * 16 * 288 + ks * 32);
            if (ks < 2) aw[jb] = MFMA16(af, bf, aw[jb]); else if (ks < 4) aa[jb] = MFMA16(af, bf, aa[jb]); else if (ks < 8) ag[jb] = MFMA16(af, bf, ag[jb]); else av[jb] = MFMA16(af, bf, av[jb]);
        }
    }
    float rr[4][4], k2[4][4], vv[4][4], dec[4][4], asg[4][4], kkr[4][4], rkv[4];
#pragma unroll
    for (int jb = 0; jb < 4; ++jb) {
        const int ch = 64 * w + 16 * jb + r;
        const float mu_r = mu[ch], mu_k = mu[512 + ch], mu_v = mu[1024 + ch];
        const float w0 = c.in[6 + z_][l * 512 + ch], a0 = c.in[8 + z_][l * 512 + ch], kk_ = c.in[13 + z_][l * 512 + ch], ka_ = c.in[14 + z_][l * 512 + ch];
        rkv[jb] = c.in[15 + z_][l * 512 + ch];
        const float v0 = (l > 0) ? c.in[11 + z_][(l - 1) * 512 + ch] : 0.f;
#pragma unroll
        for (int e = 0; e < 4; ++e) {
            const int tok = tok0 + 4 * q4 + e; const bool hp = (tok & (T - 1)) != 0;
            const bf16* pr = P + (size_t)tok * PW + ch;
            const float cr = bf2f(pr[0]), ck = bf2f(pr[512]), cv = bf2f(pr[1024]);
            const bf16* pp = hp ? pr - PW : pr;
            const float lr_ = bf2f(pp[0]), lk_ = bf2f(pp[512]), lv_ = bf2f(pp[1024]);
            const float pr_ = hp ? lr_ : 0.f, pk_ = hp ? lk_ : 0.f, pv_ = hp ? lv_ : 0.f;
            const float r_ = cr + (pr_ - cr) * mu_r, k_ = ck + (pk_ - ck) * mu_k; float v_ = cv + (pv_ - cv) * mu_v;
            const float wl = -softplusf_(-(w0 + aw[jb][e])) - 0.5f;
            const float d_ = __expf(-__expf(wl));
            const float a_ = sigmoidf_(a0 + aa[jb][e]);
            if (l == 0) ((bf16*)(wsl + WS_VFIRST))[(size_t)tok * 512 + ch] = (bf16)f2bf(v_);
            else { const float vf = bf2f(((bf16*)(wsl + WS_VFIRST))[(size_t)tok * 512 + ch]); v_ = v_ + (vf - v_) * sigmoidf_(v0 + av[jb][e]); }
            rr[jb][e] = r_; vv[jb][e] = v_; dec[jb][e] = d_; asg[jb][e] = a_;
            kkr[jb][e] = k_ * kk_; k2[jb][e] = k_ * (1.0f + (a_ - 1.0f) * ka_);
            ((bf16*)(wsl + WS_MIXED))[(size_t)tok * 2048 + ch] = (bf16)f2bf(ag[jb][e]);
        }
    }
    float kkn[4][4], bpn[4][4];
#pragma unroll
    for (int e = 0; e < 4; ++e) {
        const int tok = tok0 + 4 * q4 + e;
        float ss = 0.f;
#pragma unroll
        for (int jb = 0; jb < 4; ++jb) ss += kkr[jb][e] * kkr[jb][e];
        ss += __shfl_xor(ss, 1); ss += __shfl_xor(ss, 2); ss += __shfl_xor(ss, 4); ss += __shfl_xor(ss, 8);
        const float rn = rsqrtf(ss + 1e-6f);
        float bs = 0.f;
#pragma unroll
        for (int jb = 0; jb < 4; ++jb) {
            const int ch = 64 * w + 16 * jb + r;
            kkn[jb][e] = kkr[jb][e] * rn; bpn[jb][e] = kkn[jb][e] * asg[jb][e];
            ((float*)(wsl + WS_V))[(size_t)tok * 512 + ch] = vv[jb][e];
            bs += rr[jb][e] * k2[jb][e] * rkv[jb];
        }
#pragma unroll
        for (int o = 1; o < 16; o <<= 1) bs += __shfl_xor(bs, o);
        if (r == 0) *(f32x4*)(rsc_ + ((size_t)tok * 8 + w) * 4) = (f32x4){0.f, 0.f, bs, 0.f};
    }
    const int cq = u * 8 + w;
    bf16* AHp = (bf16*)(wsl + WS_RW) + (size_t)cq * 1024; bf16* RHp = (bf16*)(wsl + WS_RW + 16 * MiB) + (size_t)cq * 1024;
    bf16* BKp = (bf16*)(wsl + WS_RW + 32 * MiB) + (size_t)cq * 2048; float* NMp = (float*)(wsl + WS_RW + 64 * MiB) + (size_t)cq * 1024;
    float* G15p = (float*)(wsl + WS_RW + 96 * MiB) + (size_t)cq * 64;
    LAS bf16* nst = (LAS bf16*)(lds + 16384 + w * 14336);
    LAS bf16* bkl = nst + 4608;
#pragma unroll
    for (int jb = 0; jb < 4; ++jb) {
        const int j = 16 * jb + r;
        const float g0 = dec[jb][0], g1 = g0 * dec[jb][1], g2 = g1 * dec[jb][2], g3 = g2 * dec[jb][3];
        const float t0 = __shfl(g3, r), t1 = __shfl(g3, r + 16), t2 = __shfl(g3, r + 32), t3 = __shfl(g3, r + 48);
        const float pre = (q4 == 0) ? 1.0f : (q4 == 1) ? t0 : (q4 == 2) ? t0 * t1 : t0 * t1 * t2;
        const float g15 = (t0 * t1) * (t2 * t3);
        const float gam[4] = {pre * g0, pre * g1, pre * g2, pre * g3};
        const float gpv[4] = {pre, pre * g0, pre * g1, pre * g2};
        if (q4 == 0) G15p[j] = g15;
#pragma unroll
        for (int e = 0; e < 4; ++e) {
            const int t = 4 * q4 + e;
            const float ah = -kkn[jb][e] * gpv[e], rh = rr[jb][e] * gam[e], inv = __builtin_amdgcn_rcpf(gam[e]);
            const float bh = bpn[jb][e] * inv, kh = k2[jb][e] * inv;
            bkl[j * 40 + t] = (bf16)f2bf(bh * g15); bkl[j * 40 + 16 + t] = (bf16)f2bf(kh * g15);
            nst[t * 72 + j] = (bf16)f2bf(bh); nst[1152 + t * 72 + j] = (bf16)f2bf(kh); nst[2304 + t * 72 + j] = (bf16)f2bf(ah); nst[3456 + t * 72 + j] = (bf16)f2bf(rh);
        }
    }
    asm volatile("" ::: "memory");
#pragma unroll
    for (int i = 0; i < 2; ++i) { const int idx = lane + 64 * i, t = idx >> 3, c8 = idx & 7;
        *(u32x4v*)(AHp + t * 64 + c8 * 8) = *(const LAS u32x4v*)(nst + 2304 + t * 72 + c8 * 8);
        *(u32x4v*)(RHp + t * 64 + c8 * 8) = *(const LAS u32x4v*)(nst + 3456 + t * 72 + c8 * 8); }
#pragma unroll
    for (int i = 0; i < 4; ++i) { const int idx = lane + 64 * i, j = idx >> 2, c8 = idx & 3;
        *(u32x4v*)(BKp + j * 32 + c8 * 8) = *(const LAS u32x4v*)(bkl + j * 40 + c8 * 8); }
#pragma unroll
    for (int m = 0; m < 4; ++m) {
        f32x4 acc = (f32x4){0.f, 0.f, 0.f, 0.f};
#pragma unroll
        for (int ks = 0; ks < 2; ++ks) {
            const bf16x8 fa = *(const LAS bf16x8*)(nst + (m & 1) * 1152 + r * 72 + ks * 32 + q4 * 8);
            const bf16x8 fb = *(const LAS bf16x8*)(nst + (2 + (m >> 1)) * 1152 + r * 72 + ks * 32 + q4 * 8);
            acc = MFMA16(fa, fb, acc);
        }
#pragma unroll
        for (int e = 0; e < 4; ++e) { const int sidx = 4 * q4 + e; const bool keep = (m < 2) ? (sidx < r) : (sidx <= r); if (!keep) acc[e] = 0.f; }
        if (m == 0) {
#pragma unroll
            for (int e = 0; e < 4; ++e) NMp[(4 * q4 + e) * 16 + r] = acc[e];
        }
        if (m == 1) { u32x2v o; o.x = pk2(acc[0], acc[1]); o.y = pk2(acc[2], acc[3]); *(LAS u32x2v*)(nst + 2304 + r * 24 + 4 * q4) = o; }
        if (m >= 2) { u32x2v o; o.x = pk2(acc[0], acc[1]); o.y = pk2(acc[2], acc[3]); *(u32x2v*)((bf16*)(wsl + WS_RW + 98 * MiB) + (size_t)cq * 512 + r * 32 + (m - 2) * 16 + 4 * q4) = o; }
    }
    asm volatile("" ::: "memory");
    {
        bf16* VBp = (bf16*)(wsl + WS_WR1) + (size_t)cq * 1024; bf16* VNp = (bf16*)(wsl + WS_WR0) + (size_t)cq * 1024;
#pragma unroll
        for (int jb = 0; jb < 4; ++jb) { u32x2v o; o.x = pk2(vv[jb][0], vv[jb][1]); o.y = pk2(vv[jb][2], vv[jb][3]);
            *(LAS u32x2v*)(nst + (16 * jb + r) * 24 + 4 * q4) = o; *(u32x2v*)(VBp + (16 * jb + r) * 16 + 4 * q4) = o; }
        asm volatile("" ::: "memory");
        const bf16x8 zf = (bf16x8){0, 0, 0, 0, 0, 0, 0, 0};
        const bf16x8 fn = (q4 < 2) ? *(const LAS bf16x8*)(nst + 2304 + r * 24 + q4 * 8) : zf;
#pragma unroll
        for (int ib = 0; ib < 4; ++ib) {
            const bf16x8 fv = (q4 < 2) ? *(const LAS bf16x8*)(nst + (16 * ib + r) * 24 + q4 * 8) : zf;
            const f32x4 acc = MFMA16(fv, fn, ((f32x4){0.f, 0.f, 0.f, 0.f}));
            u32x2v o; o.x = pk2(acc[0], acc[1]); o.y = pk2(acc[2], acc[3]); *(u32x2v*)(VNp + r * 64 + 16 * ib + 4 * q4) = o;
        }
    }
}
#define ROR_ADD_DUMMY 0
__device__ __forceinline__ float swap32_add(float x, float y) { asm("s_nop 1\n\tv_permlane32_swap_b32 %0, %1" : "+v"(x), "+v"(y)); return x + y; }
__device__ __forceinline__ float swap16_add(float x, float y) { asm("s_nop 1\n\tv_permlane16_swap_b32 %0, %1" : "+v"(x), "+v"(y)); return x + y; }
__device__ __forceinline__ float wave_sum_fast(float x) {
    ROR_ADD(x, 8); ROR_ADD(x, 4); ROR_ADD(x, 2); ROR_ADD(x, 1);
    float y = x; asm("" : "+v"(y)); x = swap16_add(x, y); y = x; asm("" : "+v"(y)); return swap32_add(x, y);
}
__device__ __forceinline__ void rwkv_scan(const Args& c, int bx, int l, LAS unsigned char* lds, bool dry) {
    int tid_ = threadIdx.x; asm volatile("" : "+v"(tid_)); unsigned char* wsl = c.ws; asm volatile("" : "+s"(wsl)); int z_ = 0; asm volatile("" : "+s"(z_));
    const int tid = tid_, L = tid & 63, w = __builtin_amdgcn_readfirstlane(tid >> 6), r = L & 15, q4 = L >> 4;
    const int hh = bx * 2 + (w >> 2), wq = w & 3, b = hh >> 3, h = hh & 7;
    LAS unsigned char* wl = lds + w * 5376;
    LAS bf16* St = (LAS bf16*)wl;
    LAS bf16* UVl = (LAS bf16*)wl;
    LAS float* Xl = (LAS float*)(wl + 2304);
    LAS float* Nl = (LAS float*)(wl + 3392);
    LAS float* Gl = (LAS float*)(wl + 4416);
    LAS bf16* XRl = (LAS bf16*)(wl + 4672);
    const bf16* AHb = (const bf16*)(wsl + WS_RW); const bf16* RHb = (const bf16*)(wsl + WS_RW + 16 * MiB); const bf16* BKb = (const bf16*)(wsl + WS_RW + 32 * MiB);
    const float* NMb = (const float*)(wsl + WS_RW + 64 * MiB); const bf16* NRb = (const bf16*)(wsl + WS_RW + 98 * MiB); const float* G15b = (const float*)(wsl + WS_RW + 96 * MiB);
    const bf16* VNb = (const bf16*)(wsl + WS_WR0); const bf16* VBb = (const bf16*)(wsl + WS_WR1);
    float* Yb = (float*)(wsl + WS_P) + (size_t)b * T * (PW / 2) + h * 64 + 16 * wq;
    f32x4 ST[4];
#pragma unroll
    for (int jb = 0; jb < 4; ++jb) ST[jb] = (f32x4){0.f, 0.f, 0.f, 0.f};
    bf16x8 pA[2], pR[2], pB[4], pNR; f32x4 pN; u32x2v pC; u32x4v pVB[2]; float pG;
    const int row = L & 15;
#define CQ_(N_) (((size_t)b * (T / 16) + (N_)) * 8 + h)
#define GLD(TY, UB, OFF) (*(const TY*)((const char*)(UB) + (OFF)))
    const unsigned oA = (unsigned)(r * 64 + q4 * 8) * 2u, oB = (unsigned)(r * 32 + q4 * 8) * 2u, oC = (unsigned)(r * 64 + 16 * wq + 4 * q4) * 2u, oN = (unsigned)L * 16u, oV = (unsigned)(16 * wq + row) * 32u, oG = (unsigned)L * 4u;
#define PF_AR(N_) do { const size_t cq_ = CQ_(N_); const bf16* ua = AHb + cq_ * 1024; const bf16* ur = RHb + cq_ * 1024; pA[0] = GLD(bf16x8, ua, oA); pA[1] = GLD(bf16x8, ua, oA + 64u); pR[0] = GLD(bf16x8, ur, oA); pR[1] = GLD(bf16x8, ur, oA + 64u); } while (0)
#define PF_BG(N_) do { const size_t cq_ = CQ_(N_); const bf16* ub = BKb + cq_ * 2048; _Pragma("unroll") for (int jb = 0; jb < 4; ++jb) pB[jb] = GLD(bf16x8, ub, oB + (unsigned)jb * 1024u); pG = GLD(float, G15b + cq_ * 64, oG); } while (0)
#define PF_N(N_) do { pN = GLD(f32x4, NMb + CQ_(N_) * 1024, oN); } while (0)
#define PF_NR(N_) do { pNR = GLD(bf16x8, NRb + CQ_(N_) * 512, oB); } while (0)
#define PF_C(N_) do { pC = GLD(u32x2v, VNb + CQ_(N_) * 1024, oC); } while (0)
#define PF_VB(N_) do { const bf16* uv = VBb + CQ_(N_) * 1024; pVB[0] = GLD(u32x4v, uv, oV); pVB[1] = GLD(u32x4v, uv, oV + 16u); } while (0)
#define FENCE() asm volatile("" ::: "memory")
    PF_AR(0); PF_C(0); PF_BG(0); PF_N(0); PF_NR(0); PF_VB(0);
    for (int n = 0; n < T / 16; ++n) {
        const bool more = (n + 1 < T / 16);
        *(LAS f32x4*)(Nl + L * 4) = pN;
        if (more) PF_N(n + 1);
#pragma unroll
        for (int jb = 0; jb < 4; ++jb) { u32x2v o; o.x = pk2(ST[jb][0], ST[jb][1]); o.y = pk2(ST[jb][2], ST[jb][3]); *(LAS u32x2v*)(St + r * 72 + 16 * jb + 4 * q4) = o; }
        FENCE();
        {
            f32x4 xa = (f32x4){bflo(pC.x), bfhi(pC.x), bflo(pC.y), bfhi(pC.y)}, xr = (f32x4){0.f, 0.f, 0.f, 0.f};
#pragma unroll
            for (int ks = 0; ks < 2; ++ks) { const bf16x8 fs = *(const LAS bf16x8*)(St + r * 72 + ks * 32 + q4 * 8); xa = MFMA16(fs, pA[ks], xa); xr = MFMA16(fs, pR[ks], xr); }
#pragma unroll
            for (int e = 0; e < 4; ++e) Xl[(4 * q4 + e) * 17 + r] = xa[e];
            u32x2v xo; xo.x = pk2(xr[0], xr[1]); xo.y = pk2(xr[2], xr[3]); *(LAS u32x2v*)(XRl + r * 20 + 4 * q4) = xo;
        }
        if (more) { PF_AR(n + 1); PF_C(n + 1); }
        FENCE();
        float uu[16];
        {
            const LAS float* xrow = Xl + row * 17;
#pragma unroll
            for (int t = 0; t < 16; ++t) uu[t] = xrow[t];
#pragma unroll
            for (int s0 = 0; s0 < 15; ++s0) {
#pragma unroll
                for (int t4 = (s0 + 1) & ~3; t4 < 16; t4 += 4) {
                    const f32x4 nab = *(const LAS f32x4*)(Nl + s0 * 16 + t4);
#pragma unroll
                    for (int e = 0; e < 4; ++e) if (t4 + e > s0) uu[t4 + e] += uu[s0] * nab[e];
                }
            }
        }
        FENCE();
#pragma unroll
        for (int g = 0; g < 2; ++g) { u32x4v o; o.x = pk2(uu[8 * g], uu[8 * g + 1]); o.y = pk2(uu[8 * g + 2], uu[8 * g + 3]); o.z = pk2(uu[8 * g + 4], uu[8 * g + 5]); o.w = pk2(uu[8 * g + 6], uu[8 * g + 7]); *(LAS u32x4v*)(UVl + row * 40 + 8 * g) = o;
            *(LAS u32x4v*)(UVl + row * 40 + 16 + 8 * g) = pVB[g]; }
        Gl[L] = pG;
        FENCE();
        {
            const bf16x8 fu = *(const LAS bf16x8*)(UVl + r * 40 + q4 * 8);
#pragma unroll
            for (int jb = 0; jb < 4; ++jb) { const f32x4 cG = *(const LAS f32x4*)(Gl + 16 * jb + 4 * q4); ST[jb] = MFMA16(pB[jb], fu, ST[jb] * cG); }
            const u32x2v xo = *(const LAS u32x2v*)(XRl + r * 20 + 4 * q4);
            const f32x4 yv = MFMA16(fu, pNR, ((f32x4){bflo(xo.x), bfhi(xo.x), bflo(xo.y), bfhi(xo.y)}));
            if (!dry) *(f32x4*)(Yb + ((size_t)n * 16 + r) * (PW / 2) + 4 * q4) = yv;
        }
        FENCE();
        if (more) { PF_BG(n + 1); PF_NR(n + 1); PF_VB(n + 1); }
    }
#undef CQ_
#undef GLD
#undef PF_AR
#undef PF_BG
#undef PF_N
#undef PF_NR
#undef PF_VB
#undef PF_C
#undef FENCE
}
__device__ __forceinline__ void rwkv_post(const Args& c, int l, int gw, int ngw) {
    int tid_ = threadIdx.x; asm volatile("" : "+v"(tid_)); unsigned char* wsl = c.ws; asm volatile("" : "+s"(wsl)); int z_ = 0; asm volatile("" : "+s"(z_));
    float* rwb_ = (l == 0) ? c.out : (float*)(wsl + WS_RW); float* rsc_ = (float*)(wsl + (l == 0 ? WS_SC0 : WS_SC1));
    const int i = tid_ & 63;
    const float* Y = (const float*)(wsl + WS_P); const float* V = (const float*)(wsl + WS_V); bf16* MX = (bf16*)(wsl + WS_MIXED);
    for (int it0 = gw; it0 < M * 8; it0 += 8 * ngw) {
        float y[8], vv[8], g[8], bs[8], lw[8], lb[8];
#pragma unroll
        for (int q = 0; q < 8; ++q) { const int it = it0 + q * ngw; const int itc = (it < M * 8) ? it : it0;
            const int h = itc & 7; const size_t tok = (size_t)(itc >> 3); const int ch = h * 64 + i;
            y[q] = Y[tok * (PW / 2) + ch]; vv[q] = V[tok * 512 + ch]; g[q] = bf2f(MX[tok * 2048 + ch]); bs[q] = rsc_[(tok * 8 + h) * 4 + 2];
            lw[q] = c.in[16 + z_][l * 512 + ch]; lb[q] = c.in[17 + z_][l * 512 + ch]; }
#pragma unroll
        for (int q = 0; q < 8; ++q) { const int it = it0 + q * ngw;
            const float mean = wave_sum_fast(y[q]) * (1.f / 64.f); const float d = y[q] - mean;
            const float var = wave_sum_fast(d * d) * (1.f / 64.f);
            const float yn = d * rsqrtf(var + 64e-5f) * lw[q] + lb[q];
            if (it < M * 8) { const int h = it & 7; const size_t tok = (size_t)(it >> 3); MX[tok * 2048 + h * 64 + i] = (bf16)f2bf((yn + bs[q] * vv[q]) * g[q]); } }
    }
}
__device__ __forceinline__ void gdn_prep_unit(const Args& c, int ug, int l, LAS unsigned char* lds) {
    int tid_ = threadIdx.x; asm volatile("" : "+v"(tid_)); unsigned char* wsl = c.ws; asm volatile("" : "+s"(wsl)); int z_ = 0; asm volatile("" : "+s"(z_));
    const int tid = tid_, lane = tid & 63, w = __builtin_amdgcn_readfirstlane(tid >> 6), r = lane & 15, q4 = lane >> 4;
    const int h = ug & 3, chunk = (ug >> 2) & 31, b = ug >> 7;
    const size_t tok0 = (size_t)b * T + 64 * chunk;
    LAS float* kf = (LAS float*)lds;
    LAS float* vf = kf + 64 * 132;
    LAS float* Mm = vf + 64 * 132;
    LAS float* gcs = Mm + 64 * 68;
    LAS float* bet = gcs + 64;
    LAS float* egs = bet + 64;
    LAS bf16* kb = (LAS bf16*)(egs + 64);
    LAS bf16* qb = kb + 64 * 136;
    const bf16* P = ((bf16*)(wsl + WS_P));
    const float* cw = c.in[18 + z_] + (size_t)l * 4 * 1536;
    __syncthreads();
    const int tl = tid >> 3, sub = tid & 7;
    float qv[16], kv[16];
    {
        float xv[16];
#pragma unroll
        for (int sec = 0; sec < 3; ++sec) {
            float acc[16];
#pragma unroll
            for (int e = 0; e < 16; ++e) acc[e] = 0.f;
#pragma unroll
            for (int i = 0; i < 4; ++i) {
                const int tin = 64 * chunk + tl - 3 + i; const bool ok = tin >= 0;
                const bf16* src = P + (tok0 + (ok ? tl - 3 + i : tl)) * PW + GDN_BASE + sec * 512 + h * 128 + sub * 16;
                const u32x4v a0 = *(const u32x4v*)src, a1 = *(const u32x4v*)(src + 8); float f[16]; unpack8(a0, f); unpack8(a1, f + 8);
                const f32x4* wp = (const f32x4*)(cw + i * 1536 + sec * 512 + h * 128 + sub * 16);
                const float okf = ok ? 1.f : 0.f;
#pragma unroll
                for (int e4 = 0; e4 < 4; ++e4) { const f32x4 wv = wp[e4];
                    acc[4 * e4] += f[4 * e4] * wv.x * okf; acc[4 * e4 + 1] += f[4 * e4 + 1] * wv.y * okf; acc[4 * e4 + 2] += f[4 * e4 + 2] * wv.z * okf; acc[4 * e4 + 3] += f[4 * e4 + 3] * wv.w * okf; }
            }
#pragma unroll
            for (int e = 0; e < 16; ++e) acc[e] = acc[e] * sigmoidf_(acc[e]);
            if (sec < 2) {
                float ss = 0.f;
#pragma unroll
                for (int e = 0; e < 16; ++e) ss += acc[e] * acc[e];
                ss += __shfl_xor(ss, 1); ss += __shfl_xor(ss, 2); ss += __shfl_xor(ss, 4);
                const float rn = rsqrtf(ss + 1e-6f) * (sec == 0 ? 0.08838834764831845f : 1.0f);
#pragma unroll
                for (int e = 0; e < 16; ++e) { if (sec == 0) qv[e] = acc[e] * rn; else kv[e] = acc[e] * rn; }
            } else {
#pragma unroll
                for (int e = 0; e < 16; ++e) xv[e] = acc[e];
            }
        }
#pragma unroll
        for (int e = 0; e < 16; e += 4) {
            *(LAS f32x4*)(kf + tl * 132 + sub * 16 + e) = (f32x4){kv[e], kv[e + 1], kv[e + 2], kv[e + 3]};
            *(LAS f32x4*)(vf + tl * 132 + sub * 16 + e) = (f32x4){xv[e], xv[e + 1], xv[e + 2], xv[e + 3]};
        }
        u32x4v o;
        o.x = pk2(kv[0], kv[1]); o.y = pk2(kv[2], kv[3]); o.z = pk2(kv[4], kv[5]); o.w = pk2(kv[6], kv[7]); *(LAS u32x4v*)(kb + tl * 136 + sub * 16) = o;
        o.x = pk2(kv[8], kv[9]); o.y = pk2(kv[10], kv[11]); o.z = pk2(kv[12], kv[13]); o.w = pk2(kv[14], kv[15]); *(LAS u32x4v*)(kb + tl * 136 + sub * 16 + 8) = o;
        o.x = pk2(qv[0], qv[1]); o.y = pk2(qv[2], qv[3]); o.z = pk2(qv[4], qv[5]); o.w = pk2(qv[6], qv[7]); *(LAS u32x4v*)(qb + tl * 136 + sub * 16) = o;
        o.x = pk2(qv[8], qv[9]); o.y = pk2(qv[10], qv[11]); o.z = pk2(qv[12], qv[13]); o.w = pk2(qv[14], qv[15]); *(LAS u32x4v*)(qb + tl * 136 + sub * 16 + 8) = o;
        if (sub == 0) {
            const float a_ = bf2f(P[(tok0 + tl) * PW + GDN_BASE + 2048 + h]), b_ = bf2f(P[(tok0 + tl) * PW + GDN_BASE + 2052 + h]);
            bet[tl] = sigmoidf_(b_);
            gcs[tl] = -__expf(c.in[19 + z_][l * 4 + h]) * softplusf_(a_ + c.in[20 + z_][l * 4 + h]);
        }
    }
    __syncthreads();
    if (w == 0) {
        float x = gcs[lane];
#pragma unroll
        for (int o = 1; o < 64; o <<= 1) { const float y = __shfl_up(x, o); if (lane >= o) x += y; }
        gcs[lane] = x; egs[lane] = __expf(x);
    }
    __syncthreads();
    {
        const float eg = egs[tl], ek = __expf(gcs[63] - gcs[tl]);
        bf16* qd = ((bf16*)(wsl + WS_H + 32 * MiB)) + (size_t)ug * 8192 + tl * 128 + sub * 16;
        u32x4v o;
        o.x = pk2(qv[0] * eg, qv[1] * eg); o.y = pk2(qv[2] * eg, qv[3] * eg); o.z = pk2(qv[4] * eg, qv[5] * eg); o.w = pk2(qv[6] * eg, qv[7] * eg); *(u32x4v*)qd = o;
        o.x = pk2(qv[8] * eg, qv[9] * eg); o.y = pk2(qv[10] * eg, qv[11] * eg); o.z = pk2(qv[12] * eg, qv[13] * eg); o.w = pk2(qv[14] * eg, qv[15] * eg); *(u32x4v*)(qd + 8) = o;
        bf16* kd = ((bf16*)(wsl + WS_H + 48 * MiB)) + (size_t)ug * 8192 + (sub * 16) * 64 + tl;
#pragma unroll
        for (int e = 0; e < 16; ++e) kd[e * 64] = (bf16)f2bf(kv[e] * ek);
        if (tid == 0) (((float*)(wsl + WS_GL)))[ug] = egs[63];
    }
    {
        const int ib = w >> 1;
#pragma unroll
        for (int jj = 0; jj < 2; ++jj) {
            const int jb = 2 * (w & 1) + jj;
            f32x4 ckk = (f32x4){0.f, 0.f, 0.f, 0.f}, cqk = ckk;
#pragma unroll
            for (int ks = 0; ks < 4; ++ks) {
                const bf16x8 ak = *(const LAS bf16x8*)(kb + (16 * ib + r) * 136 + ks * 32 + q4 * 8);
                const bf16x8 aq = *(const LAS bf16x8*)(qb + (16 * ib + r) * 136 + ks * 32 + q4 * 8);
                const bf16x8 bk = *(const LAS bf16x8*)(kb + (16 * jb + r) * 136 + ks * 32 + q4 * 8);
                ckk = MFMA16(ak, bk, ckk); cqk = MFMA16(aq, bk, cqk);
            }
            const int j = 16 * jb + r; const float gj = gcs[j];
#pragma unroll
            for (int e = 0; e < 4; ++e) {
                const int i = 16 * ib + 4 * q4 + e;
                const float dcy = (i >= j) ? __expf(gcs[i] - gj) : 0.f;
                Mm[i * 68 + j] = (i > j) ? bet[i] * ckk[e] * dcy : 0.f;
                ((bf16*)(wsl + WS_AT))[(size_t)ug * 4096 + i * 64 + j] = (bf16)f2bf(cqk[e] * dcy);
            }
        }
    }
    __syncthreads();
    if (tid < 256) {
        const int col = tid & 127; const bool isw = tid >= 128;
        int vz = 0; asm volatile("" : "+v"(vz));
        const LAS float* Mz = Mm + vz; const LAS float* betz = bet + vz; const LAS float* egz = egs + vz;
        float x[64];
#pragma unroll
        for (int i = 0; i < 64; ++i) x[i] = isw ? kf[i * 132 + col] * betz[i] * egz[i] : vf[i * 132 + col] * betz[i];
#pragma unroll
        for (int i = 1; i < 64; ++i) {
            float s0 = x[i], s1 = 0.f, s2 = 0.f, s3 = 0.f;
#pragma unroll
            for (int m4 = 0; m4 < i; m4 += 4) {
                const f32x4 mv = *(const LAS f32x4*)(Mz + i * 68 + m4);
                s0 -= mv.x * x[m4];
                if (m4 + 1 < i) s1 -= mv.y * x[m4 + 1];
                if (m4 + 2 < i) s2 -= mv.z * x[m4 + 2];
                if (m4 + 3 < i) s3 -= mv.w * x[m4 + 3];
            }
            const float s = (s0 + s1) + (s2 + s3);
            x[i] = s;
        }
        if (!isw) {
            bf16* ut = ((bf16*)(wsl + WS_H)) + (size_t)ug * 8192 + col * 64;
#pragma unroll
            for (int i = 0; i < 64; i += 8) { u32x4v o; o.x = pk2(x[i], x[i + 1]); o.y = pk2(x[i + 2], x[i + 3]); o.z = pk2(x[i + 4], x[i + 5]); o.w = pk2(x[i + 6], x[i + 7]); *(u32x4v*)(ut + i) = o; }
        } else {
            bf16* gw = ((bf16*)(wsl + WS_H + 16 * MiB)) + (size_t)ug * 8192 + col;
#pragma unroll
            for (int i = 0; i < 64; ++i) gw[i * 128] = (bf16)f2bf(x[i]);
        }
    }
}
__device__ __forceinline__ void gdn_scan(const Args& c, int bh, int l, LAS unsigned char* lds) {
    int tid_ = threadIdx.x; asm volatile("" : "+v"(tid_)); unsigned char* wsl = c.ws; asm volatile("" : "+s"(wsl)); int z_ = 0; asm volatile("" : "+s"(z_));
    const int tid = tid_, lane = tid & 63, w = __builtin_amdgcn_readfirstlane(tid >> 6), r = lane & 15, q4 = lane >> 4;
    const int b = bh >> 2, h = bh & 3;
    LAS bf16* St = (LAS bf16*)lds;
    LAS bf16* VNt = St + 128 * 136;
    LAS bf16* Wl = VNt + 128 * 72;
    LAS bf16* Ql = Wl + 64 * 136;
    LAS bf16* Zl = Ql + 64 * 136;
    LAS bf16* Al = Zl + 64 * 136;
    LAS bf16* Kl = Al + 64 * 72;
    LAS float* red = (LAS float*)(Kl + 128 * 72);
    const int v = 16 * w + r;
    const float nw = c.in[21 + z_][l * 128 + v];
    const bf16* UTb = (const bf16*)(wsl + WS_H); const bf16* GWb = (const bf16*)(wsl + WS_H + 16 * MiB); const bf16* QDb = (const bf16*)(wsl + WS_H + 32 * MiB);
    const bf16* KDb = (const bf16*)(wsl + WS_H + 48 * MiB); const bf16* ATb = (const bf16*)(wsl + WS_AT); const float* GLb = (const float*)(wsl + WS_GL);
    const bf16* Pz = (const bf16*)(wsl + WS_P) + GDN_BASE + 1536 + h * 128;
    bf16* MX = (bf16*)(wsl + WS_MIXED) + 512 + h * 128;
    f32x4 S[8];
#pragma unroll
    for (int ib = 0; ib < 8; ++ib) S[ib] = (f32x4){0.f, 0.f, 0.f, 0.f};
    u32x4v pw[2], pq[2], pz[2], pk[2], pa; u32x2v pu[4]; float pgl;
    const int r16 = tid >> 4, c16 = tid & 15, r8 = tid >> 3, c8 = tid & 7;
#define GDN_PREFETCH(CH) do { const int ug_ = (b * 32 + (CH)) * 4 + h; const size_t t0_ = (size_t)b * T + 64 * (CH); \
        _Pragma("unroll") for (int i = 0; i < 2; ++i) { \
            pw[i] = *(const u32x4v*)(GWb + (size_t)ug_ * 8192 + (r16 + 32 * i) * 128 + c16 * 8); \
            pq[i] = *(const u32x4v*)(QDb + (size_t)ug_ * 8192 + (r16 + 32 * i) * 128 + c16 * 8); \
            pz[i] = *(const u32x4v*)(Pz + (t0_ + r16 + 32 * i) * PW + c16 * 8); \
            pk[i] = *(const u32x4v*)(KDb + (size_t)ug_ * 8192 + (r8 + 64 * i) * 64 + c8 * 8); } \
        pa = *(const u32x4v*)(ATb + (size_t)ug_ * 4096 + r8 * 64 + c8 * 8); \
        _Pragma("unroll") for (int tb = 0; tb < 4; ++tb) pu[tb] = *(const u32x2v*)(UTb + (size_t)ug_ * 8192 + v * 64 + 16 * tb + 4 * q4); \
        pgl = GLb[ug_]; } while (0)
    GDN_PREFETCH(0);
    for (int ch = 0; ch < 32; ++ch) {
        const size_t tok0 = (size_t)b * T + 64 * ch;
        __syncthreads();
#pragma unroll
        for (int i = 0; i < 2; ++i) {
            *(LAS u32x4v*)(Wl + (r16 + 32 * i) * 136 + c16 * 8) = pw[i]; *(LAS u32x4v*)(Ql + (r16 + 32 * i) * 136 + c16 * 8) = pq[i];
            *(LAS u32x4v*)(Zl + (r16 + 32 * i) * 136 + c16 * 8) = pz[i]; *(LAS u32x4v*)(Kl + (r8 + 64 * i) * 72 + c8 * 8) = pk[i];
        }
        *(LAS u32x4v*)(Al + r8 * 72 + c8 * 8) = pa;
        u32x2v uc[4];
#pragma unroll
        for (int tb = 0; tb < 4; ++tb) uc[tb] = pu[tb];
        const float gl = pgl;
#pragma unroll
        for (int ib = 0; ib < 8; ++ib) { u32x2v o; o.x = pk2(S[ib][0], S[ib][1]); o.y = pk2(S[ib][2], S[ib][3]); *(LAS u32x2v*)(St + v * 136 + 16 * ib + 4 * q4) = o; }
        if (ch + 1 < 32) GDN_PREFETCH(ch + 1);
        __syncthreads();
        f32x4 aW[4], aQ[4];
#pragma unroll
        for (int tb = 0; tb < 4; ++tb) { aW[tb] = (f32x4){0.f, 0.f, 0.f, 0.f}; aQ[tb] = aW[tb]; }
#pragma unroll
        for (int ks = 0; ks < 4; ++ks) {
            const bf16x8 bs = *(const LAS bf16x8*)(St + v * 136 + ks * 32 + q4 * 8);
#pragma unroll
            for (int tb = 0; tb < 4; ++tb) {
                const bf16x8 fw = *(const LAS bf16x8*)(Wl + (16 * tb + r) * 136 + ks * 32 + q4 * 8);
                const bf16x8 fq = *(const LAS bf16x8*)(Ql + (16 * tb + r) * 136 + ks * 32 + q4 * 8);
                aW[tb] = MFMA16(fw, bs, aW[tb]); aQ[tb] = MFMA16(fq, bs, aQ[tb]);
            }
        }
#pragma unroll
        for (int tb = 0; tb < 4; ++tb) {
            const float n0 = bflo(uc[tb].x) - aW[tb][0], n1 = bfhi(uc[tb].x) - aW[tb][1], n2 = bflo(uc[tb].y) - aW[tb][2], n3 = bfhi(uc[tb].y) - aW[tb][3];
            u32x2v o; o.x = pk2(n0, n1); o.y = pk2(n2, n3); *(LAS u32x2v*)(VNt + v * 72 + 16 * tb + 4 * q4) = o;
        }
        BAR_LDS();
#pragma unroll
        for (int ib = 0; ib < 8; ++ib) S[ib] = S[ib] * gl;
#pragma unroll
        for (int ks = 0; ks < 2; ++ks) {
            const bf16x8 bv = *(const LAS bf16x8*)(VNt + v * 72 + ks * 32 + q4 * 8);
#pragma unroll
            for (int tb = 0; tb < 4; ++tb) { const bf16x8 fa = *(const LAS bf16x8*)(Al + (16 * tb + r) * 72 + ks * 32 + q4 * 8); aQ[tb] = MFMA16(fa, bv, aQ[tb]); }
#pragma unroll
            for (int ib = 0; ib < 8; ++ib) { const bf16x8 fk = *(const LAS bf16x8*)(Kl + (16 * ib + r) * 72 + ks * 32 + q4 * 8); S[ib] = MFMA16(fk, bv, S[ib]); }
        }
#pragma unroll
        for (int tb = 0; tb < 4; ++tb)
#pragma unroll
            for (int e = 0; e < 4; ++e) {
                float ss = aQ[tb][e] * aQ[tb][e];
                ROR_ADD(ss, 8); ROR_ADD(ss, 4); ROR_ADD(ss, 2); ROR_ADD(ss, 1);
                if (r == 0) red[w * 64 + 16 * tb + 4 * q4 + e] = ss;
            }
        BAR_LDS();
#pragma unroll
        for (int tb = 0; tb < 4; ++tb)
#pragma unroll
            for (int e = 0; e < 4; ++e) {
                const int tk = 16 * tb + 4 * q4 + e; float tot = 0.f;
#pragma unroll
                for (int k = 0; k < 8; ++k) tot += red[k * 64 + tk];
                const float rstd = rsqrtf(tot * (1.f / 128.f) + 1e-6f);
                const float z = bf2f(Zl[tk * 136 + v]);
                MX[(tok0 + tk) * 2048 + v] = (bf16)f2bf(aQ[tb][e] * rstd * nw * z * sigmoidf_(z));
            }
    }
#undef GDN_PREFETCH
    __syncthreads();
}
__device__ __forceinline__ void attn_unit(const Args& c, int l, int b, int h, int qb, float lam, float lam_init, LAS unsigned char* lds) {
    int tid_ = threadIdx.x; asm volatile("" : "+v"(tid_)); unsigned char* wsl = c.ws; asm volatile("" : "+s"(wsl)); int z_ = 0; asm volatile("" : "+s"(z_));
    const int tid = tid_, lane = tid & 63, w = __builtin_amdgcn_readfirstlane(tid >> 6), r = lane & 15, q4 = lane >> 4;
    LAS bf16* Kt = (LAS bf16*)lds;
    LAS bf16* Vs = Kt + 128 * 136;
    const bf16* P = ((bf16*)(wsl + WS_P));
    const size_t seq0 = (size_t)b * T;
    const int QC = DIFF_BASE + h * 128, KC = DIFF_BASE + 1024 + h * 128, VC = DIFF_BASE + 2048 + h * 128;
    const float* qnw = c.in[22 + z_] + l * 64; const float* knw = c.in[23 + z_] + l * 64;
    bf16x8 qf[2][2];
    {
        const bf16* qrow = P + (seq0 + 128 * qb + 16 * w + r) * PW + QC;
#pragma unroll
        for (int m = 0; m < 2; ++m) {
            float f[16];
            unpack8(*(const u32x4v*)(qrow + m * 64 + q4 * 8), f); unpack8(*(const u32x4v*)(qrow + m * 64 + 32 + q4 * 8), f + 8);
            float ss = 0.f;
#pragma unroll
            for (int e = 0; e < 16; ++e) ss += f[e] * f[e];
            ss += __shfl_xor(ss, 16); ss += __shfl_xor(ss, 32);
            const float sc = rsqrtf(ss * (1.f / 64.f) + 1e-6f) * (0.125f * 1.4426950408889634f);
#pragma unroll
            for (int ks = 0; ks < 2; ++ks) { u32x4v o; const float* g = f + 8 * ks; const float* wn = qnw + ks * 32 + q4 * 8;
                o.x = pk2(g[0] * sc * wn[0], g[1] * sc * wn[1]); o.y = pk2(g[2] * sc * wn[2], g[3] * sc * wn[3]); o.z = pk2(g[4] * sc * wn[4], g[5] * sc * wn[5]); o.w = pk2(g[6] * sc * wn[6], g[7] * sc * wn[7]);
                qf[m][ks] = __builtin_bit_cast(bf16x8, o); }
        }
    }
    f32x4 O[2][8];
#pragma unroll
    for (int m = 0; m < 2; ++m)
#pragma unroll
        for (int vb = 0; vb < 8; ++vb) O[m][vb] = (f32x4){0.f, 0.f, 0.f, 0.f};
    float mrow[2] = {-INFINITY, -INFINITY}, lrow[2] = {0.f, 0.f};
    const int NT = qb + 1;
    const int skey = tid >> 3, part = tid & 7;
    const float* kwp = knw + (part & 3) * 16;
    u32x4v gk0[2], gk1[2], gv0[2], gv1[2];
#define ATT_FETCH(KT) do { _Pragma("unroll") for (int hh = 0; hh < 2; ++hh) { const bf16* krow = P + (seq0 + 128 * (KT) + 64 * hh + skey) * PW; \
        gk0[hh] = *(const u32x4v*)(krow + KC + part * 16); gk1[hh] = *(const u32x4v*)(krow + KC + part * 16 + 8); \
        gv0[hh] = *(const u32x4v*)(krow + VC + part * 16); gv1[hh] = *(const u32x4v*)(krow + VC + part * 16 + 8); } } while (0)
    ATT_FETCH(0);
    typedef short v4i16_t __attribute__((ext_vector_type(4)));
    const int r4 = (lane & 15) >> 2, c4 = lane & 3;
    for (int kt = 0; kt < NT; ++kt) {
        __syncthreads();
#pragma unroll
        for (int hh = 0; hh < 2; ++hh) {
            const int kr = skey + 64 * hh;
            float f[16]; unpack8(gk0[hh], f); unpack8(gk1[hh], f + 8);
            float kw[16];
#pragma unroll
            for (int e4 = 0; e4 < 4; ++e4) { const f32x4 t4 = ((const f32x4*)kwp)[e4]; kw[4 * e4] = t4.x; kw[4 * e4 + 1] = t4.y; kw[4 * e4 + 2] = t4.z; kw[4 * e4 + 3] = t4.w; }
            float ss = 0.f;
#pragma unroll
            for (int e = 0; e < 16; ++e) ss += f[e] * f[e];
            ss += __shfl_xor(ss, 1); ss += __shfl_xor(ss, 2);
            const float sc = rsqrtf(ss * (1.f / 64.f) + 1e-6f);
            u32x4v o;
            o.x = pk2(f[0] * sc * kw[0], f[1] * sc * kw[1]); o.y = pk2(f[2] * sc * kw[2], f[3] * sc * kw[3]); o.z = pk2(f[4] * sc * kw[4], f[5] * sc * kw[5]); o.w = pk2(f[6] * sc * kw[6], f[7] * sc * kw[7]);
            *(LAS u32x4v*)(Kt + kr * 136 + part * 16) = o;
            o.x = pk2(f[8] * sc * kw[8], f[9] * sc * kw[9]); o.y = pk2(f[10] * sc * kw[10], f[11] * sc * kw[11]); o.z = pk2(f[12] * sc * kw[12], f[13] * sc * kw[13]); o.w = pk2(f[14] * sc * kw[14], f[15] * sc * kw[15]);
            *(LAS u32x4v*)(Kt + kr * 136 + part * 16 + 8) = o;
            *(LAS u32x4v*)(Vs + kr * 136 + part * 16) = gv0[hh]; *(LAS u32x4v*)(Vs + kr * 136 + part * 16 + 8) = gv1[hh];
        }
        if (kt + 1 < NT) ATT_FETCH(kt + 1);
        __syncthreads();
        bf16x8 pf[2][4];
#pragma unroll
        for (int m = 0; m < 2; ++m) {
            f32x4 s[8];
#pragma unroll
            for (int kb = 0; kb < 8; ++kb) {
                s[kb] = (f32x4){0.f, 0.f, 0.f, 0.f};
#pragma unroll
                for (int ks = 0; ks < 2; ++ks) { const bf16x8 a = *(const LAS bf16x8*)(Kt + (16 * kb + r) * 136 + m * 64 + ks * 32 + q4 * 8); s[kb] = MFMA16(a, qf[m][ks], s[kb]); }
            }
            if (kt == qb) {
                const int qpos = 128 * qb + 16 * w + r;
#pragma unroll
                for (int kb = 0; kb < 8; ++kb)
#pragma unroll
                    for (int e = 0; e < 4; ++e) if (128 * kt + 16 * kb + 4 * q4 + e > qpos) s[kb][e] = -INFINITY;
            }
            float mx = -INFINITY;
#pragma unroll
            for (int kb = 0; kb < 8; ++kb)
#pragma unroll
                for (int e = 0; e < 4; ++e) mx = fmaxf(mx, s[kb][e]);
            mx = fmaxf(mx, __shfl_xor(mx, 16)); mx = fmaxf(mx, __shfl_xor(mx, 32));
            const float mnew = fmaxf(mrow[m], mx);
            const float alpha = __builtin_amdgcn_exp2f(mrow[m] - mnew);
            mrow[m] = mnew;
            float ps = 0.f;
#pragma unroll
            for (int kb = 0; kb < 8; ++kb)
#pragma unroll
                for (int e = 0; e < 4; ++e) { s[kb][e] = __builtin_amdgcn_exp2f(s[kb][e] - mnew); ps += s[kb][e]; }
            lrow[m] = lrow[m] * alpha + ps;
            if (__builtin_amdgcn_ballot_w64(alpha != 1.0f) != 0ull) {
#pragma unroll
                for (int vb = 0; vb < 8; ++vb) O[m][vb] = O[m][vb] * alpha;
            }
#pragma unroll
            for (int s2 = 0; s2 < 4; ++s2) { u32x4v o; o.x = pk2(s[2 * s2][0], s[2 * s2][1]); o.y = pk2(s[2 * s2][2], s[2 * s2][3]); o.z = pk2(s[2 * s2 + 1][0], s[2 * s2 + 1][1]); o.w = pk2(s[2 * s2 + 1][2], s[2 * s2 + 1][3]);
                pf[m][s2] = __builtin_bit_cast(bf16x8, o); }
        }
#pragma unroll
        for (int vb = 0; vb < 8; ++vb)
#pragma unroll
            for (int s2 = 0; s2 < 4; ++s2) {
                const v4i16_t lo = __builtin_amdgcn_ds_read_tr16_b64_v4i16((LAS v4i16_t*)(Vs + (32 * s2 + 4 * q4 + r4) * 136 + 16 * vb + 4 * c4));
                const v4i16_t hi = __builtin_amdgcn_ds_read_tr16_b64_v4i16((LAS v4i16_t*)(Vs + (32 * s2 + 16 + 4 * q4 + r4) * 136 + 16 * vb + 4 * c4));
                const bf16x8 vfr = (bf16x8){lo[0], lo[1], lo[2], lo[3], hi[0], hi[1], hi[2], hi[3]};
                O[0][vb] = MFMA16(vfr, pf[0][s2], O[0][vb]); O[1][vb] = MFMA16(vfr, pf[1][s2], O[1][vb]);
            }
    }
#undef ATT_FETCH
    float l0 = lrow[0], l1 = lrow[1];
    l0 += __shfl_xor(l0, 16); l0 += __shfl_xor(l0, 32); l1 += __shfl_xor(l1, 16); l1 += __shfl_xor(l1, 32);
    const float i0 = 1.0f / l0, i1 = lam / l1;
    float ss = 0.f;
#pragma unroll
    for (int vb = 0; vb < 8; ++vb)
#pragma unroll
        for (int e = 0; e < 4; ++e) { const float o = O[0][vb][e] * i0 - O[1][vb][e] * i1; O[0][vb][e] = o; ss += o * o; }
    ss += __shfl_xor(ss, 16); ss += __shfl_xor(ss, 32);
    const float rstd = rsqrtf(ss * (1.f / 128.f) + 1e-6f) * (1.0f - lam_init);
    const float* sw = c.in[28 + z_] + l * 128;
    bf16* orow = ((bf16*)(wsl + WS_MIXED)) + (seq0 + 128 * qb + 16 * w + r) * 2048 + 1024 + h * 128;
#pragma unroll
    for (int vb = 0; vb < 8; ++vb) { const int v0 = 16 * vb + 4 * q4; u32x2v o;
        o.x = pk2(O[0][vb][0] * rstd * sw[v0], O[0][vb][1] * rstd * sw[v0 + 1]); o.y = pk2(O[0][vb][2] * rstd * sw[v0 + 2], O[0][vb][3] * rstd * sw[v0 + 3]);
        *(u32x2v*)(orow + v0) = o; }
}

__device__ __forceinline__ void m1_phase(const Args& c, int l, LAS unsigned char* lds, int G, int mode) {
    int tid_ = threadIdx.x; asm volatile("" : "+v"(tid_)); unsigned char* wsl = c.ws; asm volatile("" : "+s"(wsl)); int z_ = 0; asm volatile("" : "+s"(z_));
    if (mode & 1) for (int u = blockIdx.x; u < 1024; u += G) rwkv_prep_unit(c, u, l, lds);
    if (mode & 2) for (int u = blockIdx.x; u < 1024; u += G) gdn_prep_unit(c, u, l, lds);
}
__device__ __forceinline__ void m2_phase(const Args& c, int l, LAS unsigned char* lds, int G, int mode, bool dry, int cidx) {
    int tid_ = threadIdx.x; asm volatile("" : "+v"(tid_)); unsigned char* wsl = c.ws; asm volatile("" : "+s"(wsl)); int z_ = 0; asm volatile("" : "+s"(z_));
    const int bx = blockIdx.x;
    unsigned* rdone = ((unsigned*)(wsl + WS_CTL)) + 64 * (8 + cidx);
    if (bx < 32) { if (mode & 1) { rwkv_scan(c, bx, l, lds, dry);
            __threadfence(); __syncthreads(); if (tid_ == 0) __hip_atomic_fetch_add(rdone, 1u, __ATOMIC_RELAXED, __HIP_MEMORY_SCOPE_AGENT); } }
    else if (bx < 64) { if (mode & 2) gdn_scan(c, bx - 32, l, lds); }
    if (!(mode & 4)) return;
    float d1 = c.in[24 + z_][l * 64 + (tid_ & 63)] * c.in[25 + z_][l * 64 + (tid_ & 63)], d2 = c.in[26 + z_][l * 64 + (tid_ & 63)] * c.in[27 + z_][l * 64 + (tid_ & 63)];
    d1 = wave_sum(d1); d2 = wave_sum(d2);
    const float lam_init = 0.8f - 0.6f * expf(-0.3f * (float)l);
    const float lam = expf(d1) - expf(d2) + lam_init;
    LAS int* slot = (LAS int*)(lds + LDS_BYTES - 64);
    for (int k8 = 0; k8 < 8; ++k8) {
        const int qx = (bx + k8) & 7;
        unsigned* ctr = ((unsigned*)(wsl + WS_CTL)) + 8192 + 64 * (cidx * 8 + qx);
        for (;;) {
            __syncthreads();
            if (tid_ == 0) *slot = (int)atomicAdd(ctr, 1u);
            __syncthreads();
            const int q = *slot;
            if (q >= 128) break;
            const int qb = 15 - (q >> 3);
            attn_unit(c, l, q & 7, qx, qb, lam, lam_init, lds);
        }
    }
    if (mode == 7 && !dry) {
        if (tid_ == 0) { unsigned sp = 0; while (__hip_atomic_load(rdone, __ATOMIC_RELAXED, __HIP_MEMORY_SCOPE_AGENT) < 32u) { __builtin_amdgcn_s_sleep(8); if (++sp > (1u << 24)) break; }
            __threadfence(); }
        __syncthreads();
        const int G8 = G * NWAVES, vcu8 = ((G % 8 == 0) ? (bx % 8) * (G / 8) + bx / 8 : bx) * NWAVES + __builtin_amdgcn_readfirstlane(tid_ >> 6);
        rwkv_post(c, l, vcu8, G8);
    }
}
#define XB_TMO      128
#define XB_XCNT(j)  (256  + 64 * (j))
#define XB_XSUB(j)  (1280 + 64 * (j))
#define XB_XGEN(j)  (2304 + 64 * (j))
#define XB_TOP      3328
#define XB_TOPGEN   3392
#define XCD_BAR_WORDS 3456
#define XB_SPIN_CAP (1u << 18)

__device__ __forceinline__ unsigned xb_ld(unsigned* p)              { return __hip_atomic_load(p, __ATOMIC_RELAXED, __HIP_MEMORY_SCOPE_AGENT); }
__device__ __forceinline__ unsigned xb_add(unsigned* p, unsigned v) { return __hip_atomic_fetch_add(p, v, __ATOMIC_RELAXED, __HIP_MEMORY_SCOPE_AGENT); }
__device__ __forceinline__ unsigned xb_xcc_id() { return (unsigned)__builtin_amdgcn_s_getreg((3 << 11) | 20) & 0xFu; }
#define XB_SPIN(cond, bar) do { unsigned _sp = 0; while (cond) { __builtin_amdgcn_s_sleep(1); \
    if ((++_sp & 255u) == 0u) { if (xb_ld(&(bar)[XB_TMO])) break; if (_sp > XB_SPIN_CAP) { atomicAdd(&(bar)[XB_TMO], 1u); break; } } } } while (0)

struct XcdBarrier {
    unsigned* bar; unsigned x;
    volatile LAS unsigned* st;
};

__device__ __forceinline__ XcdBarrier xcd_barrier_post(unsigned* bar, volatile LAS unsigned* st) {
    XcdBarrier b; b.bar = bar; b.x = xb_xcc_id(); b.st = st;
    if (threadIdx.x == 0) (void)xb_add(&bar[XB_XCNT(b.x)], 1u);
    return b;
}
__device__ __forceinline__ void xcd_barrier_complete(unsigned* bar, unsigned x, unsigned& nloc, unsigned& nx) {
    const unsigned G = gridDim.x * gridDim.y * gridDim.z;
    unsigned sum, cnt, mine, sp = 0u;
    for (;;) {
        sum = 0u; cnt = 0u; mine = 0u;
#pragma unroll
        for (unsigned j = 0; j < 16; ++j) { const unsigned c = xb_ld(&bar[XB_XCNT(j)]); sum += c; cnt += (c > 0u) ? 1u : 0u; mine = (j == x) ? c : mine; }
        if (sum == G) break;
        __builtin_amdgcn_s_sleep(1);
        if ((++sp & 255u) == 0u) { if (xb_ld(&bar[XB_TMO])) break; if (sp > XB_SPIN_CAP) { atomicAdd(&bar[XB_TMO], 1u); break; } }
    }
    nloc = mine > 0u ? mine : 1u; nx = cnt > 0u ? cnt : 1u;
}

__device__ __forceinline__ void xcd_barrier(const XcdBarrier& b) {
    asm volatile("s_waitcnt vmcnt(0)" ::: "memory");
    __syncthreads();
    if (threadIdx.x == 0) {
        unsigned* bar = b.bar;
        __builtin_amdgcn_s_waitcnt(0);
        unsigned nloc = b.st[0], nx = b.st[1];
        if (nloc == 0u) { xcd_barrier_complete(bar, b.x, nloc, nx); b.st[0] = nloc; b.st[1] = nx; }
        const unsigned old = xb_add(&bar[XB_XSUB(b.x)], 1u);
        const unsigned gen = old / nloc;
        if (old + 1u == (gen + 1u) * nloc) {
            __builtin_amdgcn_fence(__ATOMIC_RELEASE, "agent");
            asm volatile("s_waitcnt vmcnt(0)" ::: "memory");
            const unsigned og = xb_add(&bar[XB_TOP], 1u);
            const unsigned tg = og / nx;
            if (og + 1u == (tg + 1u) * nx) xb_add(&bar[XB_TOPGEN], 1u);
            else XB_SPIN(xb_ld(&bar[XB_TOPGEN]) == tg, bar);
            __builtin_amdgcn_fence(__ATOMIC_ACQUIRE, "agent");
            xb_add(&bar[XB_XGEN(b.x)], 1u);
            asm volatile("s_waitcnt vmcnt(0)" ::: "memory");
        } else {
            XB_SPIN(xb_ld(&bar[XB_XGEN(b.x)]) == gen, bar);
            __builtin_amdgcn_fence(__ATOMIC_ACQUIRE, "agent");
            asm volatile("s_waitcnt vmcnt(0)" ::: "memory");
        }
    }
    __syncthreads();
}

#ifndef DUP_K
#define DUP_K -1
#endif
#ifndef DUP_SUB
#define DUP_SUB 7
#endif
#ifndef PH_ON
#define PH_ON 63
#endif
__global__ void __launch_bounds__(NTHR, 2) fwd_kernel(Args args) {
    extern __shared__ __attribute__((aligned(16))) unsigned char lds_raw[];
    LAS unsigned char* lds = (LAS unsigned char*)lds_raw;
    const Args& c = args;
    const int G = gridDim.x, bx = blockIdx.x;
    const int vcu = (G % 8 == 0) ? (bx % 8) * (G / 8) + bx / 8 : bx;
    cg::grid_group grid = cg::this_grid();
    for (int u = threadIdx.x; u < 32; u += NTHR) ((LAS unsigned*)(lds + LDS_BYTES - 128))[u] = 0u;
    __syncthreads();
    XcdBarrier xbar = xcd_barrier_post((unsigned*)(c.ws + WS_CTL) + 1024, (volatile LAS unsigned*)(lds + LDS_BYTES - 32));
    int nsync = 0;
#define GRID_SYNC() do { if (nsync == 0) grid.sync(); else xcd_barrier(xbar); ++nsync; } while (0)
    for (int ph = args.ph_lo; ph < args.ph_hi; ++ph) {
        const int l = (ph == 0) ? 0 : (ph - 1) / 9, k = (ph == 0) ? 0 : ((ph - 1) % 9) + 1;
        if (k == 4) continue;
        const int reps = (k == DUP_K) ? 2 : 1;
        for (int rep = 0; rep < reps; ++rep) {
        if (rep) GRID_SYNC();
        if (k == 0 || k == 9) { if (PH_ON & 1) prep_phase(c, (k == 0) ? 0 : l + 1, lds, vcu, G); }
        else if (k == 1) { pg8::Gemm g{((bf16*)(c.ws + WS_H)), ((bf16*)(c.ws + WS_WIN)), M, PW, D}; pg8::StaticOrder S; S.init(M, PW, G, bx); pg8::EpiBf16 E{((bf16*)(c.ws + WS_P)), PW};
            if (PH_ON & 2) pg8::gemm_phase<pg8::EpiBf16, pg8::StaticOrder, true, true>(lds, g, S, E); }
        else if (k == 2) { if (PH_ON & 4) m1_phase(c, l, lds, G, (reps == 2 && rep == 0) ? DUP_SUB : 3); }
        else if (k == 3) { if (PH_ON & 8) { if (reps == 1) m2_phase(c, l, lds, G, 7, false, l); else if (rep == 0) m2_phase(c, l, lds, G, DUP_SUB, true, l + 2); else m2_phase(c, l, lds, G, 7, false, l); } }
        else if (k == 4) { int t4 = threadIdx.x; asm volatile("" : "+v"(t4)); rwkv_post(c, l, vcu * NWAVES + __builtin_amdgcn_readfirstlane(t4 >> 6), G * NWAVES); }
        else if (k == 5 || k == 8) { pg8::Gemm g{(k == 5) ? ((bf16*)(c.ws + WS_MIXED)) : ((bf16*)(c.ws + WS_P)), (k == 5) ? ((bf16*)(c.ws + WS_WOUT)) : ((bf16*)(c.ws + WS_WFO)), M, D, (k == 5) ? D : FF}; pg8::StaticOrder S; S.init(M, D, G, bx);
            pg8::EpiResAdd E{(k == 5 && l == 0) ? c.in[0] : c.out, c.out, D};
            if (PH_ON & 16) pg8::gemm_phase<pg8::EpiResAdd, pg8::StaticOrder, true, true>(lds, g, S, E); }
        else if (k == 6) { int t5 = threadIdx.x; asm volatile("" : "+v"(t5)); const int wave = __builtin_amdgcn_readfirstlane(t5 >> 6); norm_rows(c.out, c.in[30] + (size_t)l * D, (bf16*)(c.ws + WS_H), vcu * NWAVES + wave, G * NWAVES, t5 & 63); }
        else if (k == 7) { pg8::Gemm g{((bf16*)(c.ws + WS_H)), ((bf16*)(c.ws + WS_WFI)), M, 2 * FF, D}; pg8::StaticOrder S; S.init(M, 2 * FF, G, bx); pg8::EpiSwiglu E{((bf16*)(c.ws + WS_P)), FF};
            if (PH_ON & 32) pg8::gemm_phase<pg8::EpiSwiglu, pg8::StaticOrder, true, true>(lds, g, S, E); }
        }
        if (ph + 1 < args.ph_hi) GRID_SYNC();
#if defined(DUP_SYNC)
        GRID_SYNC();
#endif
    }
}

#ifndef ONE_LAUNCH
#define ONE_LAUNCH 1
#endif
constexpr int N_PHASES = 18;
extern "C" void kernel_launch(void* const* d_in, const int* in_sizes, int n_in, void* d_out, int out_size, void* d_ws, size_t ws_size, hipStream_t stream) {
    static int grid = 0;
    if (grid == 0) {
        if (n_in != 33 || out_size != M * D || ws_size < WS_END) { fprintf(stderr, "kernel_launch: unexpected shapes (n_in %d out %d ws %zu, need %zu)\n", n_in, out_size, ws_size, (size_t)WS_END); grid = -1; return; }
        int dev = 0, cus = 0, per_cu = 0;
        hipGetDevice(&dev); hipDeviceGetAttribute(&cus, hipDeviceAttributeMultiprocessorCount, dev);
        if (hipFuncSetAttribute((const void*)fwd_kernel, hipFuncAttributeMaxDynamicSharedMemorySize, LDS_BYTES) != hipSuccess) { fprintf(stderr, "kernel_launch: hipFuncSetAttribute failed\n"); grid = -1; return; }
        if (hipOccupancyMaxActiveBlocksPerMultiprocessor(&per_cu, (const void*)fwd_kernel, NTHR, LDS_BYTES) != hipSuccess || per_cu < 1) { fprintf(stderr, "kernel_launch: occupancy query says %d\n", per_cu); per_cu = 1; }
        (void)hipGetLastError();
        grid = cus * 1;
        fprintf(stderr, "kernel_launch: grid %d (cus %d, per_cu %d)\n", grid, cus, per_cu);
    }
    if (grid < 0) return;
    (void)hipMemsetAsync((char*)d_ws + WS_CTL, 0, 65536, stream);
    Args a{};
    for (int i = 0; i < 33; ++i) a.in[i] = (const float*)d_in[i];
    a.out = (float*)d_out; a.ws = (unsigned char*)d_ws;
#if ONE_LAUNCH
    a.ph_lo = 0; a.ph_hi = N_PHASES;
    void* kargs[] = {&a};
    hipError_t e = hipLaunchCooperativeKernel((const void*)fwd_kernel, dim3(grid), dim3(NTHR), kargs, LDS_BYTES, stream);
    if (e != hipSuccess) fprintf(stderr, "kernel_launch: cooperative launch failed: %s\n", hipGetErrorString(e));
#else
    for (int ph = 0; ph < N_PHASES; ++ph) { a.ph_lo = ph; a.ph_hi = ph + 1; hipLaunchKernelGGL(fwd_kernel, dim3(grid), dim3(NTHR), LDS_BYTES, stream, a); }
#endif
}
```
